# Optimizing an MI355X kernel written in HIP

```python
import math
import jax
import jax.numpy as jnp
from jax import lax
import numpy as np

D_MODEL = 2048
BATCH = 1
SEQ = 8192
DEPTH = 2
DEC_BATCH = 16
DEC_SEQ = 64
PAST_LEN = 2048

CHUNK = 64
N_EVEN = (DEPTH + 1) // 2
N_ODD = DEPTH // 2
N_HEADS = 16
N_KV_HEADS = 2
HEAD_DIM = 64
Q_PER_KV = N_HEADS // N_KV_HEADS
WINDOW = 128
WINDOW_CHUNKS = WINDOW // CHUNK
BAND = (WINDOW_CHUNKS + 1) * CHUNK
D_ATTN = N_HEADS * HEAD_DIM
D_KV = N_KV_HEADS * HEAD_DIM
GM_CHUNK = 128
D_GM = D_MODEL // 2
N_GM_GROUPS = 16
GM_GROUP_DIM = D_GM // N_GM_GROUPS
D_IN0 = D_ATTN + 2 * D_KV + 2 * D_GM
D_MIX0 = D_ATTN + D_GM
S5_GROUP = 16
N_S5_GROUPS = D_MODEL // S5_GROUP
S5_STATE = 64
DT_MIN = 0.001
DT_MAX = 0.1
D_FF = ((8 * D_MODEL + 3 * 256 - 1) // (3 * 256)) * 256
RMS_EPS = 1e-5
NEG_INF = -1e30

kernel_name = "hybrid_swa_sink_gmlp_s5_stream_step"


def _rmsnorm(x, g):
    xf = x.astype(jnp.float32)
    y = xf * lax.rsqrt(jnp.mean(xf * xf, axis=-1, keepdims=True) + RMS_EPS)
    return (y * g.astype(jnp.float32)).astype(x.dtype)


def _swiglu_block(x, g, w_gate, w_up, w_down):
    h = _rmsnorm(x, g)
    y = (jax.nn.silu(h @ w_gate) * (h @ w_up)) @ w_down
    return x + y.astype(x.dtype)


def _alibi_slopes():
    return jnp.exp2(-8.0 * jnp.arange(1, N_HEADS + 1, dtype=jnp.float32) / N_HEADS)


def _sink_attention(q, k, v, q_pos, k_pos, k_valid, sinks):
    s = jnp.einsum('bnqkrd,bnskd->bnkrqs', q.astype(jnp.float32), k.astype(jnp.float32)) * (HEAD_DIM ** -0.5)
    slopes = _alibi_slopes().reshape(N_KV_HEADS, Q_PER_KV)
    dist = jnp.abs(q_pos[:, :, None] - k_pos[:, None, :]).astype(jnp.float32)
    s = s - slopes[None, None, :, :, None, None] * dist[None, :, None, None, :, :]
    s = jnp.where(k_valid[None, :, None, None, None, :], s, NEG_INF)
    sink = sinks.astype(jnp.float32).reshape(N_KV_HEADS, Q_PER_KV)[None, None, :, :, None, None]
    m = jnp.maximum(jnp.max(s, axis=-1, keepdims=True), sink)
    p = jnp.exp(s - m)
    denom = jnp.sum(p, axis=-1, keepdims=True) + jnp.exp(sink - m)
    return jnp.einsum('bnkrqs,bnskd->bnqkrd', p / denom, v.astype(jnp.float32))


def _split_ab(z):
    q = z[..., :D_ATTN]
    k = z[..., D_ATTN:D_ATTN + D_KV]
    v = z[..., D_ATTN + D_KV:D_ATTN + 2 * D_KV]
    gu = z[..., D_ATTN + 2 * D_KV:D_ATTN + 2 * D_KV + D_GM]
    gv = z[..., D_ATTN + 2 * D_KV + D_GM:]
    return q, k, v, gu, gv


def _gm_prepare(gu, gv, gm_norm):
    u = jax.nn.gelu(gu, approximate=False)
    v = _rmsnorm(jax.nn.gelu(gv, approximate=False), gm_norm)
    return u, v


def _gm_spatial_weights(gm_ws):
    blk = jnp.arange(GM_CHUNK) // CHUNK
    mask = blk[:, None] >= blk[None, :]
    return jnp.where(mask[None], gm_ws, jnp.zeros((), gm_ws.dtype))


def _band(z, n_chunks):
    bsz = z.shape[0]
    zp = jnp.pad(z, ((0, 0), (WINDOW_CHUNKS * CHUNK, 0), (0, 0), (0, 0)))
    zp = zp.reshape(bsz, n_chunks + WINDOW_CHUNKS, CHUNK, N_KV_HEADS, HEAD_DIM)
    return jnp.concatenate([zp[:, j:j + n_chunks] for j in range(WINDOW_CHUNKS + 1)], axis=2)


def _layer_ab_prompt(x, g_mix, w_in, sinks, gm_norm, gm_ws, gm_b, w_out):
    bsz, t_len, _ = x.shape
    n_chunks = t_len // CHUNK
    h = _rmsnorm(x, g_mix)
    q, k, v, gu, gv = _split_ab(h @ w_in)
    q = q.reshape(bsz, n_chunks, CHUNK, N_KV_HEADS, Q_PER_KV, HEAD_DIM)
    k = k.reshape(bsz, t_len, N_KV_HEADS, HEAD_DIM)
    v = v.reshape(bsz, t_len, N_KV_HEADS, HEAD_DIM)
    q_pos = jnp.arange(t_len).reshape(n_chunks, CHUNK)
    k_pos = (jnp.arange(n_chunks)[:, None] - WINDOW_CHUNKS) * CHUNK + jnp.arange(BAND)[None, :]
    o_attn = _sink_attention(q, _band(k, n_chunks), _band(v, n_chunks), q_pos, k_pos, k_pos >= 0, sinks)
    o_attn = o_attn.reshape(bsz, t_len, D_ATTN)
    u, gvn = _gm_prepare(gu, gv, gm_norm)
    gv_c = gvn.reshape(bsz, t_len // GM_CHUNK, GM_CHUNK, N_GM_GROUPS, GM_GROUP_DIM)
    sp = jnp.einsum('gts,bcsgd->bctgd', _gm_spatial_weights(gm_ws), gv_c) + gm_b.T[None, None, :, :, None]
    o_gm = u * sp.reshape(bsz, t_len, D_GM).astype(u.dtype)
    y = jnp.concatenate([o_attn.astype(x.dtype), o_gm.astype(x.dtype)], axis=-1) @ w_out
    keep = min(WINDOW, t_len)
    return x + y.astype(x.dtype), k[:, t_len - keep:], v[:, t_len - keep:]


def _layer_ab_sample(x, cache_k, cache_v, g_mix, w_in, sinks, gm_norm, gm_ws, gm_b, w_out):
    bsz, t_len, _ = x.shape
    n_past = cache_k.shape[1]
    h = _rmsnorm(x, g_mix)
    q, k, v, gu, gv = _split_ab(h @ w_in)
    q = q.reshape(bsz, 1, t_len, N_KV_HEADS, Q_PER_KV, HEAD_DIM)
    k = k.reshape(bsz, t_len, N_KV_HEADS, HEAD_DIM)
    v = v.reshape(bsz, t_len, N_KV_HEADS, HEAD_DIM)
    k_all = jnp.concatenate([cache_k.astype(k.dtype), k], axis=1)[:, None]
    v_all = jnp.concatenate([cache_v.astype(v.dtype), v], axis=1)[:, None]
    q_pos = (PAST_LEN + jnp.arange(t_len))[None]
    k_pos = jnp.concatenate([PAST_LEN - n_past + jnp.arange(n_past), PAST_LEN + jnp.arange(t_len)])[None]
    o_attn = _sink_attention(q, k_all, v_all, q_pos, k_pos, k_pos >= 0, sinks).reshape(bsz, t_len, D_ATTN)
    u, gvn = _gm_prepare(gu, gv, gm_norm)
    w_s = _gm_spatial_weights(gm_ws)[:, :t_len, :t_len]
    sp = jnp.einsum('gts,bsgd->btgd', w_s, gvn.reshape(bsz, t_len, N_GM_GROUPS, GM_GROUP_DIM))
    sp = sp + gm_b[:, :t_len].T[None, :, :, None]
    o_gm = u * sp.reshape(bsz, t_len, D_GM).astype(u.dtype)
    y = jnp.concatenate([o_attn.astype(x.dtype), o_gm.astype(x.dtype)], axis=-1) @ w_out
    return x + y.astype(x.dtype), k, v, gvn


def _complex_affine_combine(e1, e2):
    a1r, a1i, b1r, b1i = e1
    a2r, a2i, b2r, b2i = e2
    return (a2r * a1r - a2i * a1i,
            a2r * a1i + a2i * a1r,
            a2r * b1r - a2i * b1i + b2r,
            a2r * b1i + a2i * b1r + b2i)


def _s5_discretize(lam_re, lam_im, log_dt, b_re, b_im):
    dt = jnp.exp(log_dt.astype(jnp.float32))[:, None]
    lr = lam_re.astype(jnp.float32)
    li = lam_im.astype(jnp.float32)
    mag = jnp.exp(lr * dt)
    a_re = mag * jnp.cos(li * dt)
    a_im = mag * jnp.sin(li * dt)
    den = lr * lr + li * li
    nr = a_re - 1.0
    f_re = (nr * lr + a_im * li) / den
    f_im = (a_im * lr - nr * li) / den
    br = b_re.astype(jnp.float32)
    bi = b_im.astype(jnp.float32)
    bb_re = f_re[..., None] * br - f_im[..., None] * bi
    bb_im = f_re[..., None] * bi + f_im[..., None] * br
    return a_re, a_im, bb_re, bb_im


def _layer_s5(x, s0_re, s0_im, g_mix, lam_re, lam_im, log_dt, b_re, b_im, c_re, c_im, d_skip, w_glu):
    bsz, t_len, _ = x.shape
    h = _rmsnorm(x, g_mix)
    hf = h.astype(jnp.float32)
    u = hf.reshape(bsz, t_len, N_S5_GROUPS, S5_GROUP)
    a_re, a_im, bb_re, bb_im = _s5_discretize(lam_re, lam_im, log_dt, b_re, b_im)
    bu_re = jnp.einsum('gpi,btgi->btgp', bb_re, u)
    bu_im = jnp.einsum('gpi,btgi->btgp', bb_im, u)
    elems = (jnp.broadcast_to(a_re, bu_re.shape), jnp.broadcast_to(a_im, bu_re.shape), bu_re, bu_im)
    ac_re, ac_im, st_re, st_im = lax.associative_scan(_complex_affine_combine, elems, axis=1)
    if s0_re is not None:
        s0r = s0_re.astype(jnp.float32)[:, None]
        s0i = s0_im.astype(jnp.float32)[:, None]
        st_re, st_im = (ac_re * s0r - ac_im * s0i + st_re, ac_re * s0i + ac_im * s0r + st_im)
    y = (jnp.einsum('gip,btgp->btgi', c_re.astype(jnp.float32), st_re)
         - jnp.einsum('gip,btgp->btgi', c_im.astype(jnp.float32), st_im))
    y = y.reshape(bsz, t_len, D_MODEL) + d_skip.astype(jnp.float32) * hf
    zg = jax.nn.gelu(y, approximate=False) @ w_glu.astype(jnp.float32)
    out = zg[..., :D_MODEL] * jax.nn.sigmoid(zg[..., D_MODEL:])
    return x + out.astype(x.dtype), st_re[:, -1], st_im[:, -1]


def setup_inputs(seed: int = 0) -> dict:
    key = jax.random.key(seed)
    ks = jax.random.split(key, 32)

    def nrm(k, shape, scale=1.0):
        return scale * jax.random.normal(k, shape, jnp.float32)

    swa_rows = min(WINDOW, PAST_LEN)
    n_idx = jnp.arange(S5_STATE, dtype=jnp.float32)
    s5_shape = (N_ODD, N_S5_GROUPS, S5_STATE)
    return {
        "x_prompt": nrm(ks[0], (BATCH, SEQ, D_MODEL)),
        "x_sample": nrm(ks[1], (DEC_BATCH, DEC_SEQ, D_MODEL)),
        "cache_swa_k": nrm(ks[2], (N_EVEN, DEC_BATCH, swa_rows, N_KV_HEADS, HEAD_DIM)),
        "cache_swa_v": nrm(ks[3], (N_EVEN, DEC_BATCH, swa_rows, N_KV_HEADS, HEAD_DIM)),
        "state_s5_re": nrm(ks[4], (N_ODD, DEC_BATCH, N_S5_GROUPS, S5_STATE), 0.3),
        "state_s5_im": nrm(ks[5], (N_ODD, DEC_BATCH, N_S5_GROUPS, S5_STATE), 0.3),
        "norm_mix": 1.0 + nrm(ks[6], (DEPTH, D_MODEL), 0.02),
        "norm_ffn": 1.0 + nrm(ks[7], (DEPTH, D_MODEL), 0.02),
        "norm_final": 1.0 + nrm(ks[8], (D_MODEL,), 0.02),
        "w_in0": nrm(ks[9], (N_EVEN, D_MODEL, D_IN0), D_MODEL ** -0.5),
        "attn_sinks": nrm(ks[10], (N_EVEN, N_HEADS)),
        "gm_norm": 1.0 + nrm(ks[11], (N_EVEN, D_GM), 0.02),
        "gm_ws": nrm(ks[12], (N_EVEN, N_GM_GROUPS, GM_CHUNK, GM_CHUNK), GM_CHUNK ** -0.5),
        "gm_b": 1.0 + nrm(ks[13], (N_EVEN, N_GM_GROUPS, GM_CHUNK), 0.02),
        "w_out0": nrm(ks[14], (N_EVEN, D_MIX0, D_MODEL), D_MIX0 ** -0.5),
        "s5_lam_re": -0.5 + nrm(ks[15], s5_shape, 0.01),
        "s5_lam_im": math.pi * n_idx + nrm(ks[16], s5_shape, 0.01),
        "s5_log_dt": jax.random.uniform(ks[17], (N_ODD, N_S5_GROUPS), jnp.float32,
                                        math.log(DT_MIN), math.log(DT_MAX)),
        "s5_b_re": nrm(ks[18], (N_ODD, N_S5_GROUPS, S5_STATE, S5_GROUP), (2 * S5_GROUP) ** -0.5),
        "s5_b_im": nrm(ks[19], (N_ODD, N_S5_GROUPS, S5_STATE, S5_GROUP), (2 * S5_GROUP) ** -0.5),
        "s5_c_re": nrm(ks[20], (N_ODD, N_S5_GROUPS, S5_GROUP, S5_STATE), S5_STATE ** -0.5),
        "s5_c_im": nrm(ks[21], (N_ODD, N_S5_GROUPS, S5_GROUP, S5_STATE), S5_STATE ** -0.5),
        "s5_d": nrm(ks[22], (N_ODD, D_MODEL)),
        "s5_w_glu": nrm(ks[23], (N_ODD, D_MODEL, 2 * D_MODEL), D_MODEL ** -0.5),
        "ffn_w_gate": nrm(ks[24], (DEPTH, D_MODEL, D_FF), D_MODEL ** -0.5),
        "ffn_w_up": nrm(ks[25], (DEPTH, D_MODEL, D_FF), D_MODEL ** -0.5),
        "ffn_w_down": nrm(ks[26], (DEPTH, D_FF, D_MODEL), D_FF ** -0.5),
    }


def reference(x_prompt, x_sample, cache_swa_k, cache_swa_v, state_s5_re, state_s5_im,
              norm_mix, norm_ffn, norm_final, w_in0, attn_sinks, gm_norm, gm_ws, gm_b, w_out0,
              s5_lam_re, s5_lam_im, s5_log_dt, s5_b_re, s5_b_im, s5_c_re, s5_c_im, s5_d, s5_w_glu,
              ffn_w_gate, ffn_w_up, ffn_w_down):
    xp = x_prompt
    xs = x_sample
    kp_list, vp_list, ks_list, vs_list, gv_list = [], [], [], [], []
    spr_list, spi_list, ssr_list, ssi_list = [], [], [], []
    for layer in range(DEPTH):
        if layer % 2 == 0:
            e = layer // 2
            xp, kp, vp = _layer_ab_prompt(xp, norm_mix[layer], w_in0[e], attn_sinks[e], gm_norm[e],
                                          gm_ws[e], gm_b[e], w_out0[e])
            xs, ks_new, vs_new, gv_new = _layer_ab_sample(xs, cache_swa_k[e], cache_swa_v[e], norm_mix[layer],
                                                          w_in0[e], attn_sinks[e], gm_norm[e], gm_ws[e],
                                                          gm_b[e], w_out0[e])
            kp_list.append(kp)
            vp_list.append(vp)
            ks_list.append(ks_new)
            vs_list.append(vs_new)
            gv_list.append(gv_new)
        else:
            o = layer // 2
            xp, spr, spi = _layer_s5(xp, None, None, norm_mix[layer], s5_lam_re[o], s5_lam_im[o], s5_log_dt[o],
                                     s5_b_re[o], s5_b_im[o], s5_c_re[o], s5_c_im[o], s5_d[o], s5_w_glu[o])
            xs, ssr, ssi = _layer_s5(xs, state_s5_re[o], state_s5_im[o], norm_mix[layer], s5_lam_re[o],
                                     s5_lam_im[o], s5_log_dt[o], s5_b_re[o], s5_b_im[o], s5_c_re[o],
                                     s5_c_im[o], s5_d[o], s5_w_glu[o])
            spr_list.append(spr)
            spi_list.append(spi)
            ssr_list.append(ssr)
            ssi_list.append(ssi)
        xp = _swiglu_block(xp, norm_ffn[layer], ffn_w_gate[layer], ffn_w_up[layer], ffn_w_down[layer])
        xs = _swiglu_block(xs, norm_ffn[layer], ffn_w_gate[layer], ffn_w_up[layer], ffn_w_down[layer])
    y_prompt = _rmsnorm(xp, norm_final)
    y_sample = _rmsnorm(xs, norm_final)
    swa_k_prompt = jnp.stack(kp_list)
    swa_v_prompt = jnp.stack(vp_list)
    swa_k_sample = jnp.stack(ks_list)
    swa_v_sample = jnp.stack(vs_list)
    gm_v_sample = jnp.stack(gv_list)
    s5_re_prompt = jnp.stack(spr_list)
    s5_im_prompt = jnp.stack(spi_list)
    s5_re_sample = jnp.stack(ssr_list)
    s5_im_sample = jnp.stack(ssi_list)
    return (y_prompt, y_sample, swa_k_prompt, swa_v_prompt, swa_k_sample, swa_v_sample,
            gm_v_sample, s5_re_prompt, s5_im_prompt, s5_re_sample, s5_im_sample)
```

```cpp
#include <hip/hip_runtime.h>
#include <hip/hip_cooperative_groups.h>
#include <cstdio>
#include <cstdint>
namespace cg = cooperative_groups;
#ifndef DUP_P0
#define DUP_P0 0
#endif
#ifndef DUP_P2
#define DUP_P2 0
#endif
#ifndef DUP_P6
#define DUP_P6 0
#endif

#define LAS __attribute__((address_space(3)))
#define DI __device__ __forceinline__
typedef unsigned short bf16_t;
typedef short bf16x8 __attribute__((ext_vector_type(8)));
typedef float f32x4 __attribute__((ext_vector_type(4)));
typedef float f32x2 __attribute__((ext_vector_type(2)));
typedef unsigned u32x4 __attribute__((ext_vector_type(4)));
typedef unsigned u32x2 __attribute__((ext_vector_type(2)));

constexpr int MTOK = 9216, MP = 8192, DM = 2048, DIN0 = 3328, DFF = 5632;
constexpr float RMS_EPS = 1e-5f;
constexpr size_t MiB = 1u << 20;
constexpr size_t WS_RSTD0 = 0;
constexpr size_t WS_BAR   = 40 * 1024;
constexpr size_t WS_GPART = 64 * 1024;
constexpr size_t WS_PART  = 1 * MiB;
constexpr size_t WS_S5A   = 4 * MiB;
constexpr size_t WS_BBCAT = WS_S5A + 128 * 1024;
constexpr size_t WS_CCAT  = WS_BBCAT + 512 * 1024;
constexpr size_t WS_WMB   = WS_CCAT + 512 * 1024;
constexpr size_t WS_E     = 6 * MiB;
constexpr size_t WS_WIN   = 16 * MiB;
constexpr size_t WS_WOUT  = 29 * MiB;
constexpr size_t WS_WGU0  = 37 * MiB;
constexpr size_t WS_WD0   = 81 * MiB;
constexpr size_t WS_WGLU  = 103 * MiB;
constexpr size_t WS_WGU1  = 119 * MiB;
constexpr size_t WS_WD1   = 163 * MiB;
constexpr size_t WS_XB    = 185 * MiB;
constexpr size_t WS_R     = 221 * MiB;
constexpr size_t WS_QB    = WS_R;
constexpr size_t WS_UB    = WS_R + 18 * MiB;
constexpr size_t WS_GVB   = WS_R + 36 * MiB;
constexpr size_t WS_KB    = WS_R + 54 * MiB;
constexpr size_t WS_VB    = WS_R + 57 * MiB;
constexpr size_t WS_OMIX  = WS_R + 60 * MiB;
constexpr size_t WS_YB    = WS_R;
constexpr size_t WS_PB    = 320 * MiB;
constexpr size_t WS_END   = 384 * MiB;
constexpr size_t O_KP = 18874368, O_VP = 18890752, O_KS = 18907136, O_VS = 19038208, O_GV = 19169280,
                 O_SPR = 20217856, O_SPI = 20226048, O_SSR = 20234240, O_SSI = 20365312;

constexpr int LDS_BYTES = 132096;

#define LDS_WAIT() asm volatile("s_waitcnt lgkmcnt(0)" ::: "memory")
DI unsigned f2bf(float f) { unsigned u = __builtin_bit_cast(unsigned, f); return (u + 0x7fffu + ((u >> 16) & 1u)) >> 16; }
DI float bf2f(unsigned h) { return __builtin_bit_cast(float, h << 16); }
typedef __bf16 bf16x2_t __attribute__((ext_vector_type(2)));
DI unsigned cvt_pk_bf16(float lo, float hi) { const f32x2 v = {lo, hi}; const bf16x2_t b = __builtin_convertvector(v, bf16x2_t); return __builtin_bit_cast(unsigned, b); }
DI u32x4 pack8(f32x4 a, f32x4 b) { u32x4 w; w.x = cvt_pk_bf16(a[0], a[1]); w.y = cvt_pk_bf16(a[2], a[3]); w.z = cvt_pk_bf16(b[0], b[1]); w.w = cvt_pk_bf16(b[2], b[3]); return w; }
DI u32x2 pack4(f32x4 a) { u32x2 w; w.x = cvt_pk_bf16(a[0], a[1]); w.y = cvt_pk_bf16(a[2], a[3]); return w; }
DI f32x2 gelu_pk(f32x2 v) {
    const f32x2 av = __builtin_elementwise_abs(v), d = av * 0.2316418882f + 1.0f;
    f32x2 t; t.x = __builtin_amdgcn_rcpf(d.x); t.y = __builtin_amdgcn_rcpf(d.y);
    f32x2 q = t * 0.5307027145f + (-0.7265760135f); q = q * t + 0.7107068705f; q = q * t + (-0.142248368f); q = q * t + 0.127414796f; q = q * t;
    const f32x2 s = (v * v) * (-0.72134752044f);
    f32x2 e; e.x = __builtin_amdgcn_exp2f(s.x); e.y = __builtin_amdgcn_exp2f(s.y);
    const f32x2 m = v * (q * e), r = v - m;
    f32x2 o; o.x = v.x < 0.f ? m.x : r.x; o.y = v.y < 0.f ? m.y : r.y; return o;
}
DI f32x4 gelu4(f32x4 v) { f32x2 a = gelu_pk((f32x2){v[0], v[1]}), b = gelu_pk((f32x2){v[2], v[3]}); return (f32x4){a.x, a.y, b.x, b.y}; }
DI float sigmoidf_(float x) { return __builtin_amdgcn_rcpf(1.0f + __expf(-x)); }
DI float sumsq4(f32x4 v) { return (v[0] * v[0] + v[1] * v[1]) + (v[2] * v[2] + v[3] * v[3]); }

namespace pg8 {
constexpr int BM = 256, BK = 64, HALF = 128, HTB = HALF * BK * 2, STAGE_BYTES = 8 * HTB, NXCD = 8, WGM = 8;
__host__ __device__ __forceinline__ int lds_byte(int r, int c) { const int st = (r >> 4) * 2 + (c >> 5), rr = r & 15, cc = c & 31, ob = rr * 64 + cc * 2; return st * 1024 + (ob ^ (((ob >> 9) & 1) << 5)); }
__host__ __device__ __forceinline__ void stage_rc(int b, int& R, int& C) { const int st = b / 1024, sb = b % 1024, swz = sb ^ (((sb >> 9) & 1) << 5); R = (st >> 1) * 16 + swz / 64; C = (st & 1) * 32 + (swz % 64) / 2; }
__host__ __device__ __forceinline__ int perm32(int rho) { const int n = rho >> 4, i = rho & 15; return 8 * (i >> 2) + 4 * n + (i & 3); }
struct Unit { int pm, pn, k0, nkt, aux; };
struct Gemm { const bf16_t* A; const bf16_t* Bt; int M, N, K; };
struct StaticOrder {
    static constexpr bool VARK = false;
    int nM, nN, nwg, G, c;
    __host__ __device__ void init(int M, int N, int G_, int c_) { nM = M / BM; nN = N / BM; nwg = nM * nN; G = G_; c = c_; }
    __host__ __device__ bool next(int i, Unit& u) const {
        const long L = (long)i * G + c; if (L >= nwg) return false;
        int wgid = (int)L; { const int q = nwg / NXCD, r = nwg % NXCD, xcd = wgid % NXCD, off = wgid / NXCD; wgid = (xcd < r ? xcd * (q + 1) : r * (q + 1) + (xcd - r) * q) + off; }
        const int nig = WGM * nN, gid = wgid / nig, fm = gid * WGM, gsz = (nM - fm) < WGM ? (nM - fm) : WGM;
        u.pm = fm + ((wgid % nig) % gsz); u.pn = (wgid % nig) / gsz; u.k0 = 0; u.nkt = 0; u.aux = 0; return true;
    }
    __device__ __forceinline__ void a_ready(const Unit&) const {}
    __device__ __forceinline__ void done(const Unit&) const {}
};
struct SplitOrder {
    static constexpr bool VARK = true;
    StaticOrder so; int c, nkt_full;
    __host__ __device__ void init(int K, int c_) { so.init(8192, 2048, 256, c_); c = c_; nkt_full = K / BK; }
    __host__ __device__ bool next(int i, Unit& u) const {
        if (i == 0) { so.next(0, u); u.k0 = 0; u.nkt = nkt_full; u.aux = 0; return true; }
        if (i == 1) { const int su = c >> 3, pc = c & 7; u.pm = 32 + (su >> 3); u.pn = su & 7; u.aux = c;
            const int npair = nkt_full / 2, base = npair / 8, rem = npair % 8;
            const int p0 = pc < rem ? pc * (base + 1) : rem * (base + 1) + (pc - rem) * base, np = pc < rem ? base + 1 : base;
            u.k0 = 2 * p0; u.nkt = 2 * np; return true; }
        return false;
    }
    __device__ __forceinline__ void a_ready(const Unit&) const {}
    __device__ __forceinline__ void done(const Unit&) const {}
};
struct OneUnit {
    static constexpr bool VARK = false;
    int pm, pn;
    __device__ __forceinline__ bool next(int i, Unit& u) const { if (i != 0) return false; u.pm = pm; u.pn = pn; u.k0 = 0; u.nkt = 0; u.aux = 0; return true; }
    __device__ __forceinline__ void a_ready(const Unit&) const {}
    __device__ __forceinline__ void done(const Unit&) const {}
};
__host__ __device__ __forceinline__ int early_panel(int lay, int e) { return (lay == 0 || e < 11) ? e : e + 3; }
__host__ __device__ __forceinline__ int late_panel(int lay, int q) { return (lay == 0 || q >= 3) ? 24 + q : 11 + q; }
struct SkipOrder {
    static constexpr bool VARK = false;
    StaticOrder so; int G, c, lay;
    __host__ __device__ void init(int G_, int c_, int lay_) { so.init(36 * 256, 42 * 256, G_, c_); G = G_; c = c_; lay = lay_; }
    __host__ __device__ bool next(int i, Unit& u) const {
        if (so.next(i, u)) { u.pn += 2; return true; }
        const long L = (long)i * G + c - so.nwg; if (L < 0 || L >= 24) return false;
        u.pm = late_panel(lay, (int)(L >> 1)); u.pn = (int)(L & 1); u.k0 = 0; u.nkt = 0; u.aux = 0; return true;
    }
    __device__ __forceinline__ void a_ready(const Unit&) const {}
    __device__ __forceinline__ void done(const Unit&) const {}
};
template <class Epi, class Sched, bool ALIGN_EPI = false, bool SP2 = false>
__device__ __forceinline__ void gemm_phase(LAS unsigned char* lds, const Gemm g, const Sched& S, const Epi& E) {
    const int tid = threadIdx.x, wid = __builtin_amdgcn_readfirstlane(tid >> 6), lane = tid & 63, wr = wid >> 2, wc = wid & 3, fr = lane & 15, fq = lane >> 4;
    const int K = g.K, nt = K / BK;
    unsigned voffA[2], voffB[2];
#pragma unroll
    for (int i = 0; i < 2; ++i) { int R, C; stage_rc(tid * 16 + i * 8192, R, C); const int Rb = Epi::PERM ? ((R & ~31) + perm32(R & 31)) : R;
        voffA[i] = (unsigned)(R * K + C) * 2u; voffB[i] = (unsigned)(Rb * K + C) * 2u; }
    const size_t kstep = (size_t)(BK * 2);
    const size_t hstep = (size_t)HALF * K * 2;
    const size_t tstep = 2 * hstep;
    const unsigned ldsw = (unsigned)wid * 1024u;
    const int aoff = lds_byte(wr * 64 + fr, fq * 8), boff = lds_byte(wc * 32 + fr, fq * 8);
#define PG8_SA(b, h) (((b) * 2 + (h)) * HTB)
#define PG8_SB(b, h) ((4 + (b) * 2 + (h)) * HTB)
#define PG8_STAGE(bufoff, gbase, voff) do { _Pragma("unroll") for (int _i = 0; _i < 2; ++_i) \
        __builtin_amdgcn_global_load_lds((const unsigned*)((const char*)(gbase) + (voff)[_i]), (LAS unsigned*)(lds + (bufoff) + ldsw + _i * 8192), 16, 0, 0); } while (0)
#define PG8_LDA(dst, b, h) do { _Pragma("unroll") for (int m = 0; m < 4; ++m) _Pragma("unroll") for (int k = 0; k < 2; ++k) dst[m][k] = *(const LAS bf16x8*)(lds + PG8_SA(b, h) + aoff + m * 2048 + k * 1024); } while (0)
#define PG8_LDB(dst, b, h) do { _Pragma("unroll") for (int n = 0; n < 2; ++n) _Pragma("unroll") for (int k = 0; k < 2; ++k) dst[n][k] = *(const LAS bf16x8*)(lds + PG8_SB(b, h) + boff + n * 2048 + k * 1024); } while (0)
#define PG8_MMA(ai, bj, At, Bt) do { __builtin_amdgcn_s_setprio(1); _Pragma("unroll") for (int m = 0; m < 4; ++m) _Pragma("unroll") for (int n = 0; n < 2; ++n) _Pragma("unroll") for (int k = 0; k < 2; ++k) \
        acc[ai][bj][m][n] = __builtin_amdgcn_mfma_f32_16x16x32_bf16(Bt[n][k], At[m][k], acc[ai][bj][m][n], 0, 0, 0); __builtin_amdgcn_s_setprio(0); } while (0)
#define PG8_WAIT_V(n) asm volatile("s_waitcnt vmcnt(" #n ")" ::: "memory")
#define PG8_WAIT_L(n) asm volatile("s_waitcnt lgkmcnt(" #n ")" ::: "memory")
#define PG8_BAR __builtin_amdgcn_s_barrier()
#define PG8_SCHED __builtin_amdgcn_sched_barrier(0)
    Unit cur, nxt; int ui = 0;
    if (!S.next(0, cur)) return;
    f32x4 acc[2][2][4][2];
#pragma unroll
    for (int a = 0; a < 2; ++a)
#pragma unroll
        for (int b = 0; b < 2; ++b)
#pragma unroll
            for (int m = 0; m < 4; ++m)
#pragma unroll
                for (int n = 0; n < 2; ++n) acc[a][b][m][n] = (f32x4){0.f, 0.f, 0.f, 0.f};
    bf16x8 At[4][2], B0[2][2], B1[2][2];
    const char* cA = (const char*)g.A + (size_t)cur.pm * tstep; const char* cB = (const char*)g.Bt + (size_t)cur.pn * tstep;
    if constexpr (Sched::VARK) { cA += (size_t)cur.k0 * kstep; cB += (size_t)cur.k0 * kstep; }
    S.a_ready(cur);
    if constexpr (SP2) {
        PG8_STAGE(PG8_SB(0, 0), cB, voffB); PG8_STAGE(PG8_SB(0, 1), cB + hstep, voffB); PG8_STAGE(PG8_SA(0, 0), cA, voffA); PG8_STAGE(PG8_SA(0, 1), cA + hstep, voffA);
        if (wr == 1) PG8_BAR;
        PG8_WAIT_V(2); PG8_BAR;
        PG8_STAGE(PG8_SB(1, 0), cB + kstep, voffB); PG8_STAGE(PG8_SA(1, 0), cA + kstep, voffA); PG8_STAGE(PG8_SB(1, 1), cB + hstep + kstep, voffB);
        PG8_WAIT_V(6); PG8_BAR;
    } else {
        PG8_STAGE(PG8_SB(0, 0), cB, voffB); PG8_STAGE(PG8_SA(0, 0), cA, voffA); PG8_STAGE(PG8_SB(0, 1), cB + hstep, voffB); PG8_STAGE(PG8_SA(0, 1), cA + hstep, voffA);
        if (wr == 1) PG8_BAR;
        PG8_WAIT_V(4); PG8_BAR;
        PG8_STAGE(PG8_SB(1, 0), cB + kstep, voffB); PG8_STAGE(PG8_SA(1, 0), cA + kstep, voffA); PG8_STAGE(PG8_SB(1, 1), cB + hstep + kstep, voffB);
        PG8_WAIT_V(6); PG8_BAR;
    }
    for (;;) {
        const bool has_next = S.next(ui + 1, nxt);
        const char* nA = has_next ? (const char*)g.A + (size_t)nxt.pm * tstep : cA; const char* nB = has_next ? (const char*)g.Bt + (size_t)nxt.pn * tstep : cB;
        if constexpr (Sched::VARK) { if (has_next) { nA += (size_t)nxt.k0 * kstep; nB += (size_t)nxt.k0 * kstep; } }
        const int cnt = Sched::VARK ? cur.nkt : nt;
        for (int t = 0; t < cnt; t += 2) {
            const bool last = (t == cnt - 2);
            const char* a1 = cA + (size_t)(t + 1) * kstep;
            const char* a2 = last ? nA : cA + (size_t)(t + 2) * kstep; const char* b2 = last ? nB : cB + (size_t)(t + 2) * kstep;
            const char* a3 = a2 + kstep; const char* b3 = b2 + kstep;
            if (last && has_next) S.a_ready(nxt);
            if constexpr (SP2) {
            PG8_LDB(B0, 0, 0); PG8_LDB(B1, 0, 1); PG8_SCHED; PG8_LDA(At, 0, 0); PG8_STAGE(PG8_SA(1, 1), a1 + hstep, voffA);
            PG8_WAIT_V(8); PG8_WAIT_L(0); PG8_BAR; PG8_MMA(0, 0, At, B0); PG8_MMA(0, 1, At, B1); PG8_BAR; PG8_SCHED;
            PG8_LDA(At, 0, 1); PG8_STAGE(PG8_SB(0, 0), b2, voffB); PG8_STAGE(PG8_SB(0, 1), b2 + hstep, voffB); PG8_STAGE(PG8_SA(0, 0), a2, voffA);
            PG8_WAIT_V(8); PG8_WAIT_L(0); PG8_BAR; PG8_MMA(1, 0, At, B0); PG8_MMA(1, 1, At, B1); PG8_BAR; PG8_SCHED;
            PG8_LDB(B0, 1, 0); PG8_LDB(B1, 1, 1); PG8_SCHED; PG8_LDA(At, 1, 0); PG8_STAGE(PG8_SA(0, 1), a2 + hstep, voffA);
            PG8_WAIT_V(8); PG8_WAIT_L(0); PG8_BAR; PG8_MMA(0, 0, At, B0); PG8_MMA(0, 1, At, B1); PG8_BAR; PG8_SCHED;
            PG8_LDA(At, 1, 1); PG8_STAGE(PG8_SB(1, 0), b3, voffB); PG8_STAGE(PG8_SB(1, 1), b3 + hstep, voffB); PG8_STAGE(PG8_SA(1, 0), a3, voffA);
            PG8_WAIT_V(8); PG8_WAIT_L(0); PG8_BAR; PG8_MMA(1, 0, At, B0); PG8_MMA(1, 1, At, B1); PG8_BAR; PG8_SCHED;
            } else {
            PG8_LDB(B0, 0, 0); PG8_SCHED; PG8_LDA(At, 0, 0); PG8_STAGE(PG8_SA(1, 1), a1 + hstep, voffA);
            PG8_WAIT_L(8); PG8_BAR; PG8_WAIT_L(0); PG8_MMA(0, 0, At, B0); PG8_BAR; PG8_SCHED;
            PG8_LDB(B1, 0, 1); PG8_STAGE(PG8_SB(0, 0), b2, voffB);
            PG8_BAR; PG8_WAIT_L(0); PG8_MMA(0, 1, At, B1); PG8_BAR;
            PG8_LDA(At, 0, 1); PG8_STAGE(PG8_SA(0, 0), a2, voffA);
            PG8_BAR; PG8_WAIT_L(0); PG8_MMA(1, 0, At, B0); PG8_BAR; PG8_SCHED;
            PG8_STAGE(PG8_SB(0, 1), b2 + hstep, voffB);
            PG8_WAIT_V(6); PG8_BAR; PG8_MMA(1, 1, At, B1); PG8_BAR;
            PG8_LDB(B0, 1, 0); PG8_SCHED; PG8_LDA(At, 1, 0); PG8_STAGE(PG8_SA(0, 1), a2 + hstep, voffA);
            PG8_WAIT_L(8); PG8_BAR; PG8_WAIT_L(0); PG8_MMA(0, 0, At, B0); PG8_BAR; PG8_SCHED;
            PG8_LDB(B1, 1, 1); PG8_STAGE(PG8_SB(1, 0), b3, voffB);
            PG8_BAR; PG8_WAIT_L(0); PG8_MMA(0, 1, At, B1); PG8_BAR;
            PG8_LDA(At, 1, 1); PG8_STAGE(PG8_SA(1, 0), a3, voffA);
            PG8_BAR; PG8_WAIT_L(0); PG8_MMA(1, 0, At, B0); PG8_BAR; PG8_SCHED;
            PG8_STAGE(PG8_SB(1, 1), b3 + hstep, voffB);
            PG8_WAIT_V(6); PG8_BAR; PG8_MMA(1, 1, At, B1); PG8_BAR;
            }
        }
        if constexpr (ALIGN_EPI) { if (wr == 0) PG8_BAR; }
        E(acc, cur, wr, wc, fr, fq);
        if (!has_next) break;
#pragma unroll
        for (int a = 0; a < 2; ++a)
#pragma unroll
            for (int b = 0; b < 2; ++b)
#pragma unroll
                for (int m = 0; m < 4; ++m)
#pragma unroll
                    for (int n = 0; n < 2; ++n) acc[a][b][m][n] = (f32x4){0.f, 0.f, 0.f, 0.f};
        cur = nxt; cA = nA; cB = nB; ++ui;
        if constexpr (ALIGN_EPI) { if (wr == 1) PG8_BAR; }
    }
    PG8_WAIT_V(0);
    if constexpr (!ALIGN_EPI) { if (wr == 0) PG8_BAR; }
    PG8_BAR;
#undef PG8_SA
#undef PG8_SB
#undef PG8_STAGE
#undef PG8_LDA
#undef PG8_LDB
#undef PG8_MMA
#undef PG8_WAIT_V
#undef PG8_WAIT_L
#undef PG8_BAR
#undef PG8_SCHED
}
}
using pg8::Unit;

template <int NP> DI float row_rstd(const float* part, int row, int fq) {
    const float* p = part + (size_t)row * NP + fq * (NP / 4);
    float s = 0.f;
#pragma unroll
    for (int i = 0; i < NP / 4; i += 4) { const f32x4 v = *(const f32x4*)(p + i); s += (v[0] + v[1]) + (v[2] + v[3]); }
    s += __shfl_xor(s, 16); s += __shfl_xor(s, 32);
    return rsqrtf(s * (1.0f / 2048.0f) + RMS_EPS);
}

struct EpiIn {
    static constexpr bool PERM = true;
    const float* rstd0; bf16_t *qb, *kb, *vb, *ub, *gvb; float* gpart; float* out;
    DI void operator()(const f32x4 (&acc)[2][2][4][2], const Unit& u, int wr, int wc, int fr, int fq) const {
        const int pn = u.pn, rowb = u.pm * 256 + wr * 64 + fr, cw = wc * 32 + 8 * fq;
#pragma unroll
        for (int ai = 0; ai < 2; ++ai)
#pragma unroll
            for (int m = 0; m < 4; ++m) {
                const int row = rowb + ai * 128 + m * 16; const float rs = rstd0[row];
                if (pn < 4) {
#pragma unroll
                    for (int bj = 0; bj < 2; ++bj) *(u32x4*)(qb + (size_t)row * 1024 + pn * 256 + bj * 128 + cw) = pack8(acc[ai][bj][m][0] * rs, acc[ai][bj][m][1] * rs);
                } else if (pn == 4) {
#pragma unroll
                    for (int bj = 0; bj < 2; ++bj) {
                        const f32x4 v0 = acc[ai][bj][m][0] * rs, v1 = acc[ai][bj][m][1] * rs;
                        *(u32x4*)((bj ? vb : kb) + (size_t)row * 128 + cw) = pack8(v0, v1);
                        float* o = nullptr;
                        if (row >= MP) o = out + (bj ? O_VS : O_KS) + (size_t)(row - MP) * 128 + cw;
                        else if (row >= MP - 128) o = out + (bj ? O_VP : O_KP) + (size_t)(row - (MP - 128)) * 128 + cw;
                        if (o) { *(f32x4*)o = v0; *(f32x4*)(o + 4) = v1; }
                    }
                } else if (pn < 9) {
#pragma unroll
                    for (int bj = 0; bj < 2; ++bj) *(u32x4*)(ub + (size_t)row * 1024 + (pn - 5) * 256 + bj * 128 + cw) = pack8(gelu4(acc[ai][bj][m][0] * rs), gelu4(acc[ai][bj][m][1] * rs));
                } else {
                    float q = 0.f;
#pragma unroll
                    for (int bj = 0; bj < 2; ++bj) { const f32x4 v0 = gelu4(acc[ai][bj][m][0] * rs), v1 = gelu4(acc[ai][bj][m][1] * rs); q += sumsq4(v0) + sumsq4(v1);
                        *(u32x4*)(gvb + (size_t)row * 1024 + (pn - 9) * 256 + bj * 128 + cw) = pack8(v0, v1); }
                    q += __shfl_xor(q, 16); q += __shfl_xor(q, 32);
                    if (fq == 0) gpart[(size_t)row * 16 + (pn - 9) * 4 + wc] = q;
                }
            }
    }
};
struct EpiRes {
    static constexpr bool PERM = true;
    const float* base_p; const float* base_s; float* X; bf16_t* xb; float* part; float* pb; int nkt_full;
    DI void operator()(const f32x4 (&acc)[2][2][4][2], const Unit& u, int wr, int wc, int fr, int fq) const {
        if (pb && u.nkt != nkt_full) {
            float* t = pb + (size_t)u.aux * 65536 + (size_t)(wr * 64 + fr) * 256 + wc * 32 + 8 * fq;
#pragma unroll
            for (int ai = 0; ai < 2; ++ai)
#pragma unroll
                for (int m = 0; m < 4; ++m)
#pragma unroll
                    for (int bj = 0; bj < 2; ++bj) { float* o = t + (ai * 128 + m * 16) * 256 + bj * 128; *(f32x4*)o = acc[ai][bj][m][0]; *(f32x4*)(o + 4) = acc[ai][bj][m][1]; }
            return;
        }
        const int rowb = u.pm * 256 + wr * 64 + fr, cw = u.pn * 256 + wc * 32 + 8 * fq;
#pragma unroll
        for (int ai = 0; ai < 2; ++ai)
#pragma unroll
            for (int m = 0; m < 4; ++m) {
                const int row = rowb + ai * 128 + m * 16;
                const float* b = row < MP ? base_p + (size_t)row * DM : base_s + (size_t)(row - MP) * DM;
                float q = 0.f;
#pragma unroll
                for (int bj = 0; bj < 2; ++bj) { const int col = cw + bj * 128;
                    const f32x4 v0 = acc[ai][bj][m][0] + *(const f32x4*)(b + col), v1 = acc[ai][bj][m][1] + *(const f32x4*)(b + col + 4);
                    *(f32x4*)(X + (size_t)row * DM + col) = v0; *(f32x4*)(X + (size_t)row * DM + col + 4) = v1;
                    if (xb) *(u32x4*)(xb + (size_t)row * DM + col) = pack8(v0, v1);
                    q += sumsq4(v0) + sumsq4(v1); }
                q += __shfl_xor(q, 16); q += __shfl_xor(q, 32);
                if (fq == 0) part[(size_t)row * 32 + u.pn * 4 + wc] = q;
            }
    }
};
template <int NP> struct EpiSwiglu {
    static constexpr bool PERM = true;
    const float* part; bf16_t* act;
    DI void operator()(const f32x4 (&acc)[2][2][4][2], const Unit& u, int wr, int wc, int fr, int fq) const {
        const int rowb = u.pm * 256 + wr * 64 + fr, col = u.pn * 128 + wc * 32 + 8 * fq;
#pragma unroll
        for (int ai = 0; ai < 2; ++ai)
#pragma unroll
            for (int m = 0; m < 4; ++m) {
                const int row = rowb + ai * 128 + m * 16; const float rs = row_rstd<NP>(part, row, fq);
                f32x4 o[2];
#pragma unroll
                for (int n = 0; n < 2; ++n) { const f32x4 g = acc[ai][0][m][n] * rs, up = acc[ai][1][m][n] * rs;
#pragma unroll
                    for (int e = 0; e < 4; ++e) o[n][e] = g[e] * sigmoidf_(g[e]) * up[e]; }
                *(u32x4*)(act + (size_t)row * DFF + col) = pack8(o[0], o[1]);
            }
    }
};
struct EpiGlu {
    static constexpr bool PERM = true;
    float* X; bf16_t* xb; float* part;
    DI void operator()(const f32x4 (&acc)[2][2][4][2], const Unit& u, int wr, int wc, int fr, int fq) const {
        const int rowb = u.pm * 256 + wr * 64 + fr, col = u.pn * 128 + wc * 32 + 8 * fq;
#pragma unroll
        for (int ai = 0; ai < 2; ++ai)
#pragma unroll
            for (int m = 0; m < 4; ++m) {
                const int row = rowb + ai * 128 + m * 16; float* xp = X + (size_t)row * DM + col;
                f32x4 o[2];
#pragma unroll
                for (int n = 0; n < 2; ++n) { const f32x4 v = acc[ai][0][m][n], g = acc[ai][1][m][n]; const f32x4 b = *(const f32x4*)(xp + 4 * n);
#pragma unroll
                    for (int e = 0; e < 4; ++e) o[n][e] = b[e] + v[e] * sigmoidf_(g[e]); }
                *(f32x4*)xp = o[0]; *(f32x4*)(xp + 4) = o[1];
                *(u32x4*)(xb + (size_t)row * DM + col) = pack8(o[0], o[1]);
                float q = sumsq4(o[0]) + sumsq4(o[1]);
                q += __shfl_xor(q, 16); q += __shfl_xor(q, 32);
                if (fq == 0) part[(size_t)row * 64 + u.pn * 4 + wc] = q;
            }
    }
};

DI int fresh_tid() { int t; asm volatile("v_mov_b32 %0, %1" : "=v"(t) : "v"((int)threadIdx.x)); return t; }
struct Args { const float* in[27]; float* out; unsigned char* ws; };

DI float wave_sum(float v) {
#pragma unroll
    for (int o = 1; o < 64; o <<= 1) v += __shfl_xor(v, o);
    return v;
}

DI void tr_item(const float* W, int ldw, int k0, int c0, const float* gk, bf16_t* WT, int K, int drow0, LAS float* scr, int lane) {
    f32x4 v[8];
#pragma unroll
    for (int i = 0; i < 8; ++i) { const int k = 8 * i + (lane >> 3); v[i] = *(const f32x4*)(W + (size_t)(k0 + k) * ldw + c0 + (lane & 7) * 4); }
#pragma unroll
    for (int i = 0; i < 8; ++i) { const int k = 8 * i + (lane >> 3); const float sc = gk ? gk[k0 + k] : 1.0f; LAS float* d = scr + k * 33 + (lane & 7) * 4;
        d[0] = v[i][0] * sc; d[1] = v[i][1] * sc; d[2] = v[i][2] * sc; d[3] = v[i][3] * sc; }
    LDS_WAIT(); asm volatile("" ::: "memory");
    const int c = lane & 7;
#pragma unroll
    for (int j = 0; j < 4; ++j) { const int n = (lane >> 3) + 8 * j; const LAS float* s = scr + (8 * c) * 33 + n;
        u32x4 o; o.x = cvt_pk_bf16(s[0 * 33], s[1 * 33]); o.y = cvt_pk_bf16(s[2 * 33], s[3 * 33]); o.z = cvt_pk_bf16(s[4 * 33], s[5 * 33]); o.w = cvt_pk_bf16(s[6 * 33], s[7 * 33]);
        *(u32x4*)(WT + (size_t)(drow0 + n) * K + k0 + 8 * c) = o; }
    LDS_WAIT(); asm volatile("" ::: "memory");
}
DI void tr_mat(const float* W, int ldw, int csrc, int K, int N, const float* gk, bf16_t* WT, int inter, int half, LAS float* scr, int r, int lane) {
    const int nblk = N / 32, kb = r / nblk, nb = r % nblk, n0 = 32 * nb;
    const int drow0 = inter ? ((n0 >> 7) * 256 + half * 128 + (n0 & 127)) : n0;
    tr_item(W, ldw, 64 * kb, csrc + n0, gk, WT, K, drow0, scr, lane);
}

DI void sincos_f(float x, float& s, float& c) {
    const float n = rintf(x * 0.636619772367581343f);
    float r = fmaf(-n, 1.5703125f, x); r = fmaf(-n, 4.837512969970703125e-4f, r); r = fmaf(-n, 7.54978995489188216e-8f, r);
    const float z = r * r;
    const float sp = r + r * z * (-1.6666654611e-1f + z * (8.3321608736e-3f + z * (-1.9515295891e-4f)));
    const float cp = 1.0f - 0.5f * z + z * z * (4.166664568298827e-2f + z * (-1.388731625493765e-3f + z * 2.443315711809948e-5f));
    const int q = ((int)n) & 3;
    const float ss = (q & 1) ? cp : sp, cc = (q & 1) ? sp : cp;
    s = (q & 2) ? -ss : ss; c = ((q + 1) & 2) ? -cc : cc;
}

DI void attn_unit(LAS unsigned char* lds, int unit, const Args& A, const bf16_t* qb, const bf16_t* kb, const bf16_t* vb, bf16_t* omix, int tid, int wave, int lane) {
    LAS bf16_t* Ks = (LAS bf16_t*)lds;
    LAS bf16_t* Vt = (LAS bf16_t*)(lds + 27648);
    const int kh = unit & 1, cidx = unit >> 1; const bool samp = cidx >= 128; const int bs = cidx - 128;
    const float* ck = A.in[2]; const float* cv = A.in[3];
#pragma unroll
    for (int r = 0; r < 3; ++r) {
        const int idx = tid + 512 * r, key = idx >> 3, db = idx & 7;
        u32x4 kk = (u32x4){0u, 0u, 0u, 0u}, vv = (u32x4){0u, 0u, 0u, 0u};
        if (samp && key < 128) {
            const size_t o = ((size_t)(bs * 128 + key) * 2 + kh) * 64 + db * 8;
            kk = pack8(*(const f32x4*)(ck + o), *(const f32x4*)(ck + o + 4)); vv = pack8(*(const f32x4*)(cv + o), *(const f32x4*)(cv + o + 4));
        } else {
            const int row = samp ? (MP + bs * 64 + key - 128) : ((cidx - 2) * 64 + key);
            if (row >= 0) { kk = *(const u32x4*)(kb + (size_t)row * 128 + kh * 64 + db * 8); vv = *(const u32x4*)(vb + (size_t)row * 128 + kh * 64 + db * 8); }
        }
        *(LAS u32x4*)(Ks + key * 72 + db * 8) = kk;
#pragma unroll
        for (int e = 0; e < 4; ++e) { const unsigned w = vv[e]; Vt[(db * 8 + 2 * e) * 200 + key] = (bf16_t)(w & 0xffffu); Vt[(db * 8 + 2 * e + 1) * 200 + key] = (bf16_t)(w >> 16); }
    }
    __syncthreads();
    const int h = kh * 8 + wave, fr = lane & 15, quad = lane >> 4;
    const float slope = exp2f(-0.5f * (float)(h + 1)), sink = A.in[10][h];
    const int rowbase = samp ? (MP + bs * 64) : cidx * 64;
    const int kmin = samp ? 0 : (2 - cidx) * 64;
    bf16x8 bqn[2];
#pragma unroll
    for (int ks = 0; ks < 2; ++ks) bqn[ks] = *(const bf16x8*)(qb + (size_t)(rowbase + fr) * 1024 + h * 64 + ks * 32 + quad * 8);
#pragma unroll 1
    for (int qt = 0; qt < 4; ++qt) {
        const int qrow = rowbase + qt * 16 + fr;
        bf16x8 bq[2];
#pragma unroll
        for (int ks = 0; ks < 2; ++ks) bq[ks] = bqn[ks];
        if (qt < 3) {
#pragma unroll
            for (int ks = 0; ks < 2; ++ks) bqn[ks] = *(const bf16x8*)(qb + (size_t)(qrow + 16) * 1024 + h * 64 + ks * 32 + quad * 8); }
        f32x4 s[12];
#pragma unroll
        for (int kt = 0; kt < 12; ++kt) { f32x4 a = (f32x4){0.f, 0.f, 0.f, 0.f};
#pragma unroll
            for (int ks = 0; ks < 2; ++ks) { const bf16x8 ak = *(const LAS bf16x8*)(Ks + (kt * 16 + fr) * 72 + ks * 32 + quad * 8); a = __builtin_amdgcn_mfma_f32_16x16x32_bf16(ak, bq[ks], a, 0, 0, 0); }
            s[kt] = a; if (kt & 1) __builtin_amdgcn_sched_barrier(0); }
        const int qi = qt * 16 + fr;
        float mx = -1e30f;
#pragma unroll
        for (int kt = 0; kt < 12; ++kt)
#pragma unroll
            for (int j = 0; j < 4; ++j) { const int ki = kt * 16 + quad * 4 + j; const int d = 128 + qi - ki; const float dist = (float)(d < 0 ? -d : d);
                float v = s[kt][j] * 0.125f - slope * dist; if (ki < kmin) v = -1e30f; s[kt][j] = v; mx = fmaxf(mx, v); }
        mx = fmaxf(mx, __shfl_xor(mx, 16)); mx = fmaxf(mx, __shfl_xor(mx, 32)); mx = fmaxf(mx, sink);
        float sum = 0.f;
#pragma unroll
        for (int kt = 0; kt < 12; ++kt)
#pragma unroll
            for (int j = 0; j < 4; ++j) { const float p = __expf(s[kt][j] - mx); s[kt][j] = p; sum += p; }
        sum += __shfl_xor(sum, 16); sum += __shfl_xor(sum, 32);
        const float inv = 1.0f / (sum + __expf(sink - mx));
        f32x4 o[4];
#pragma unroll
        for (int dt = 0; dt < 4; ++dt) o[dt] = (f32x4){0.f, 0.f, 0.f, 0.f};
#pragma unroll
        for (int s2 = 0; s2 < 6; ++s2) {
            const u32x4 bpw = pack8(s[2 * s2] * inv, s[2 * s2 + 1] * inv); const bf16x8 bp = __builtin_bit_cast(bf16x8, bpw);
#pragma unroll
            for (int dt = 0; dt < 4; ++dt) {
                const LAS bf16_t* vp = Vt + (dt * 16 + fr) * 200 + s2 * 32 + quad * 4;
                const u32x2 lo = *(const LAS u32x2*)vp, hi = *(const LAS u32x2*)(vp + 16);
                const u32x4 avw = (u32x4){lo.x, lo.y, hi.x, hi.y};
                o[dt] = __builtin_amdgcn_mfma_f32_16x16x32_bf16(__builtin_bit_cast(bf16x8, avw), bp, o[dt], 0, 0, 0);
            }
            __builtin_amdgcn_sched_barrier(0);
        }
#pragma unroll
        for (int dt = 0; dt < 4; ++dt) *(u32x2*)(omix + (size_t)qrow * DM + h * 64 + dt * 16 + quad * 4) = pack4(o[dt]);
    }
    __syncthreads();
}

DI void gm_unit(LAS unsigned char* lds, int unit, const Args& A, const bf16_t* ub, const bf16_t* gvb, const float* gpart, const bf16_t* wmb, bf16_t* omix, int tid, int wave, int lane) {
    LAS bf16_t* vT = (LAS bf16_t*)lds;
    const bool samp = unit >= 1024; const int g = unit & 15;
    const int r0 = samp ? (MP + ((unit - 1024) >> 4) * 64) : ((unit >> 4) * 128), T = samp ? 64 : 128;
    {
        const int s = tid >> 2, dq = tid & 3;
        if (s < T) {
            const int row = r0 + s;
            const f32x4 pp = *(const f32x4*)(gpart + (size_t)row * 16 + dq * 4);
            float ss = (pp[0] + pp[1]) + (pp[2] + pp[3]); ss += __shfl_xor(ss, 1); ss += __shfl_xor(ss, 2);
            const float rs = rsqrtf(ss * (1.0f / 1024.0f) + RMS_EPS);
            const int c0 = g * 64 + dq * 16;
            const u32x4 w0 = *(const u32x4*)(gvb + (size_t)row * 1024 + c0), w1 = *(const u32x4*)(gvb + (size_t)row * 1024 + c0 + 8);
            const float* gn = A.in[11] + c0;
            float val[16];
#pragma unroll
            for (int e = 0; e < 4; ++e) { val[2 * e] = bf2f(w0[e] & 0xffffu); val[2 * e + 1] = bf2f(w0[e] >> 16); val[8 + 2 * e] = bf2f(w1[e] & 0xffffu); val[8 + 2 * e + 1] = bf2f(w1[e] >> 16); }
#pragma unroll
            for (int e = 0; e < 16; ++e) val[e] = val[e] * rs * gn[e];
            if (samp) { float* o = A.out + O_GV + (size_t)(row - MP) * 1024 + c0;
#pragma unroll
                for (int e = 0; e < 4; ++e) *(f32x4*)(o + 4 * e) = (f32x4){val[4 * e], val[4 * e + 1], val[4 * e + 2], val[4 * e + 3]}; }
#pragma unroll
            for (int e = 0; e < 16; ++e) vT[(dq * 16 + e) * 136 + s] = (bf16_t)f2bf(val[e]);
        }
    }
    __syncthreads();
    const int tt = wave, fr = lane & 15, quad = lane >> 4;
    if (tt * 16 < T) {
        const int t = tt * 16 + fr, row = r0 + t;
        const bool lowhalf = tt < 4;
        bf16x8 bw[4];
#pragma unroll
        for (int ks = 0; ks < 4; ++ks) bw[ks] = (ks < 2 || !lowhalf) ? *(const bf16x8*)(wmb + ((size_t)(g * 128 + t)) * 128 + ks * 32 + quad * 8) : (bf16x8){0, 0, 0, 0, 0, 0, 0, 0};
        const float bias = A.in[13][g * 128 + t];
#pragma unroll
        for (int dt = 0; dt < 4; ++dt) {
            f32x4 acc = (f32x4){0.f, 0.f, 0.f, 0.f};
#pragma unroll
            for (int ks = 0; ks < 4; ++ks) if (ks < 2 || !lowhalf) {
                const bf16x8 a = *(const LAS bf16x8*)(vT + (dt * 16 + fr) * 136 + ks * 32 + quad * 8);
                acc = __builtin_amdgcn_mfma_f32_16x16x32_bf16(a, bw[ks], acc, 0, 0, 0); }
            const int c = g * 64 + dt * 16 + quad * 4;
            const u32x2 uw = *(const u32x2*)(ub + (size_t)row * 1024 + c);
            f32x4 o; o[0] = bf2f(uw.x & 0xffffu) * (acc[0] + bias); o[1] = bf2f(uw.x >> 16) * (acc[1] + bias); o[2] = bf2f(uw.y & 0xffffu) * (acc[2] + bias); o[3] = bf2f(uw.y >> 16) * (acc[3] + bias);
            *(u32x2*)(omix + (size_t)row * DM + 1024 + c) = pack4(o);
        }
    }
    __syncthreads();
}

template <bool FULL> DI void s5_item(LAS unsigned char* wl, int cidx, int g, bool newchunk, int lane, const Args& A, const float* X, const float* part, const float* s5a, const bf16_t* bbcat, const bf16_t* ccat, float* E, bf16_t* yb) {
    LAS float* bu = (LAS float*)wl;
    LAS bf16_t* sb = (LAS bf16_t*)(wl + 8448);
    LAS float* rsl = (LAS float*)(wl + 8448 + 4352);
    const bool samp = cidx >= 128; const int rowbase = samp ? MP + (cidx - 128) * 64 : cidx * 64;
    if (newchunk) {
        const float* pp = part + (size_t)(rowbase + lane) * 32; float s = 0.f;
#pragma unroll
        for (int i = 0; i < 32; i += 4) { const f32x4 v = *(const f32x4*)(pp + i); s += (v[0] + v[1]) + (v[2] + v[3]); }
        rsl[lane] = rsqrtf(s * (1.0f / 2048.0f) + RMS_EPS);
    }
    const int fr = lane & 15, quad = lane >> 4;
    const bf16x8 zero8 = (bf16x8){0, 0, 0, 0, 0, 0, 0, 0};
    bf16x8 bbf[8];
#pragma unroll
    for (int nt = 0; nt < 8; ++nt) bbf[nt] = quad < 2 ? *(const bf16x8*)(bbcat + ((size_t)(g * 128 + nt * 16 + fr)) * 16 + quad * 8) : zero8;
    bf16x8 ccf[4];
    if (FULL) {
#pragma unroll
        for (int ks = 0; ks < 4; ++ks) ccf[ks] = *(const bf16x8*)(ccat + ((size_t)(g * 16 + fr)) * 128 + ks * 32 + quad * 8);
    }
    const float are = s5a[g * 64 + lane], aim = s5a[8192 + g * 64 + lane];
    float sre = 0.f, sim = 0.f;
    if (FULL) {
        if (samp) { const size_t o = ((size_t)(cidx - 128) * 128 + g) * 64 + lane; sre = A.in[4][o]; sim = A.in[5][o]; }
        else {
            const f32x2 e = *(const f32x2*)(E + ((size_t)(cidx * 128 + g) * 64 + lane) * 2); sre = e.x; sim = e.y;
        }
    }
    const float* gmix = A.in[6] + DM + g * 16;
    const f32x4 g0 = *(const f32x4*)(gmix + (quad & 1) * 8), g1 = *(const f32x4*)(gmix + (quad & 1) * 8 + 4);
    f32x4 gm = g0, dk = g0;
    if (FULL) { gm = *(const f32x4*)(gmix + quad * 4); dk = *(const f32x4*)(A.in[22] + g * 16 + quad * 4); }
#define S5_LOAD(sub_, a0, a1, av) do { const float* xr_ = X + (size_t)(rowbase + (sub_) * 16 + fr) * DM + g * 16; \
        if (quad < 2) { a0 = *(const f32x4*)(xr_ + quad * 8); a1 = *(const f32x4*)(xr_ + quad * 8 + 4); } if (FULL) av = *(const f32x4*)(xr_ + quad * 4); } while (0)
    const f32x4 z4 = (f32x4){0.f, 0.f, 0.f, 0.f};
    f32x4 n0 = z4, n1 = z4, nv = z4;
    S5_LOAD(0, n0, n1, nv);
    LDS_WAIT(); asm volatile("" ::: "memory");
#pragma unroll 1
    for (int sub = 0; sub < 4; ++sub) {
        const int row = rowbase + sub * 16 + fr; const float rr = rsl[sub * 16 + fr];
        const f32x4 c0 = n0, c1 = n1, cv = nv;
        if (sub < 3) S5_LOAD(sub + 1, n0, n1, nv);
        bf16x8 ua = zero8;
        if (quad < 2) ua = __builtin_bit_cast(bf16x8, pack8(c0 * g0 * rr, c1 * g1 * rr));
#pragma unroll
        for (int nt = 0; nt < 8; ++nt) { const f32x4 a = __builtin_amdgcn_mfma_f32_16x16x32_bf16(ua, bbf[nt], (f32x4){0.f, 0.f, 0.f, 0.f}, 0, 0, 0);
#pragma unroll
            for (int j = 0; j < 4; ++j) bu[(quad * 4 + j) * 132 + nt * 16 + fr] = a[j]; }
        LDS_WAIT(); asm volatile("" ::: "memory");
#pragma unroll
        for (int t = 0; t < 16; ++t) { const float re = bu[t * 132 + lane], im = bu[t * 132 + 64 + lane];
            const float nre = are * sre - aim * sim + re, nim = are * sim + aim * sre + im; sre = nre; sim = nim;
            if (FULL) { const unsigned w = cvt_pk_bf16(sre, sim); sb[t * 136 + lane] = (bf16_t)(w & 0xffffu); sb[t * 136 + 64 + lane] = (bf16_t)(w >> 16); } }
        if (FULL) {
            LDS_WAIT(); asm volatile("" ::: "memory");
            f32x4 y = (f32x4){0.f, 0.f, 0.f, 0.f};
#pragma unroll
            for (int ks = 0; ks < 4; ++ks) { const bf16x8 sf = *(const LAS bf16x8*)(sb + fr * 136 + ks * 32 + quad * 8); y = __builtin_amdgcn_mfma_f32_16x16x32_bf16(ccf[ks], sf, y, 0, 0, 0); }
            const f32x4 hh = cv * gm * rr;
            *(u32x2*)(yb + (size_t)row * DM + g * 16 + quad * 4) = pack4(gelu4(y + dk * hh));
        }
        LDS_WAIT(); asm volatile("" ::: "memory");
    }
#undef S5_LOAD
    if (FULL) {
        if (samp) { const size_t o = ((size_t)(cidx - 128) * 128 + g) * 64 + lane; A.out[O_SSR + o] = sre; A.out[O_SSI + o] = sim; }
        else if (cidx == 127) { A.out[O_SPR + g * 64 + lane] = sre; A.out[O_SPI + g * 64 + lane] = sim; }
    } else {
        *(f32x2*)(E + ((size_t)(cidx * 128 + g) * 64 + lane) * 2) = (f32x2){sre, sim};
    }
}

DI f32x4 pb_sum(const float* pb, int r, int col) {
    const int su = (r >> 8) * 8 + (col >> 8); const float* p = pb + (size_t)su * 8 * 65536 + (size_t)(r & 255) * 256 + (col & 255);
    f32x4 s = *(const f32x4*)p;
#pragma unroll
    for (int pc = 1; pc < 8; ++pc) s += *(const f32x4*)(p + (size_t)pc * 65536);
    return s;
}
constexpr int CV_IN = 32 * 104, CV_OUT = 32 * 64, CV_G = 32 * 176, CV_D = 88 * 64, CV_GL = 32 * 64;
constexpr int CV_A1 = CV_IN, CV_A2 = CV_A1 + CV_OUT, CV_A3 = CV_A2 + 2 * CV_G, CV_A4 = CV_A3 + 2 * CV_GL, CV_A5 = CV_A4 + CV_D, CV_A6 = CV_A5 + 2 * CV_G, CV_A7 = CV_A6 + CV_D;
DI void conv_items(const Args& A, unsigned char* ws, int first, int last, int worker, int nworkers, LAS float* scr, int lane, bool skip_early) {
    const float* nmix = A.in[6]; const float* nffn = A.in[7];
    bf16_t* Wt_in = (bf16_t*)(ws + WS_WIN); bf16_t* Wt_out = (bf16_t*)(ws + WS_WOUT); bf16_t* Wt_gu0 = (bf16_t*)(ws + WS_WGU0); bf16_t* Wt_d0 = (bf16_t*)(ws + WS_WD0);
    bf16_t* Wt_glu = (bf16_t*)(ws + WS_WGLU); bf16_t* Wt_gu1 = (bf16_t*)(ws + WS_WGU1); bf16_t* Wt_d1 = (bf16_t*)(ws + WS_WD1);
    for (int it = first + worker; it < last; it += nworkers) {
        int r = it;
        if (r < CV_IN) { tr_mat(A.in[9], DIN0, 0, DM, DIN0, nmix, Wt_in, 0, 0, scr, r, lane); continue; } r -= CV_IN;
        if (r < CV_OUT) { tr_mat(A.in[14], DM, 0, DM, DM, nullptr, Wt_out, 0, 0, scr, r, lane); continue; } r -= CV_OUT;
        if (r < CV_G) { if (!(skip_early && (r % 176) < 8)) tr_mat(A.in[24], DFF, 0, DM, DFF, nffn, Wt_gu0, 1, 0, scr, r, lane); continue; } r -= CV_G;
        if (r < CV_G) { if (!(skip_early && (r % 176) < 8)) tr_mat(A.in[25], DFF, 0, DM, DFF, nffn, Wt_gu0, 1, 1, scr, r, lane); continue; } r -= CV_G;
        if (r < CV_GL) { tr_mat(A.in[23], 2 * DM, 0, DM, DM, nullptr, Wt_glu, 1, 0, scr, r, lane); continue; } r -= CV_GL;
        if (r < CV_GL) { tr_mat(A.in[23], 2 * DM, DM, DM, DM, nullptr, Wt_glu, 1, 1, scr, r, lane); continue; } r -= CV_GL;
        if (r < CV_D) { tr_mat(A.in[26], DM, 0, DFF, DM, nullptr, Wt_d0, 0, 0, scr, r, lane); continue; } r -= CV_D;
        if (r < CV_G) { if (!(skip_early && (r % 176) < 8)) tr_mat(A.in[24] + (size_t)DM * DFF, DFF, 0, DM, DFF, nffn + DM, Wt_gu1, 1, 0, scr, r, lane); continue; } r -= CV_G;
        if (r < CV_G) { if (!(skip_early && (r % 176) < 8)) tr_mat(A.in[25] + (size_t)DM * DFF, DFF, 0, DM, DFF, nffn + DM, Wt_gu1, 1, 1, scr, r, lane); continue; } r -= CV_G;
        tr_mat(A.in[26] + (size_t)DFF * DM, DM, 0, DFF, DM, nullptr, Wt_d1, 0, 0, scr, r, lane);
    }
}
DI void conv_early(const Args& A, unsigned char* ws, int worker, int nworkers, LAS float* scr, int lane) {
    const float* nffn = A.in[7];
    for (int e = worker; e < 1024; e += nworkers) {
        const int lay = e >> 9, mat = (e >> 8) & 1, kb = (e & 255) >> 3, nb = e & 7;
        tr_mat(A.in[24 + mat] + (size_t)lay * DM * DFF, DFF, 0, DM, DFF, nffn + lay * DM, (bf16_t*)(ws + (lay ? WS_WGU1 : WS_WGU0)), 1, mat, scr, kb * 176 + nb, lane);
    }
}
#define XB_TMO      128
#define XB_XCNT(j)  (256  + 64 * (j))
#define XB_XSUB(j)  (1280 + 64 * (j))
#define XB_XGEN(j)  (2304 + 64 * (j))
#define XB_TOP      3328
#define XB_TOPGEN   3392
#define XCD_BAR_WORDS 3456
#define XB_SPIN_CAP (1u << 18)
DI unsigned xb_ld(unsigned* p)              { return __hip_atomic_load(p, __ATOMIC_RELAXED, __HIP_MEMORY_SCOPE_AGENT); }
DI unsigned xb_add(unsigned* p, unsigned v) { return __hip_atomic_fetch_add(p, v, __ATOMIC_RELAXED, __HIP_MEMORY_SCOPE_AGENT); }
DI unsigned xb_xcc_id() { return (unsigned)__builtin_amdgcn_s_getreg((3 << 11) | 20) & 0xFu; }
#define XB_SPIN(cond, bar) do { unsigned _sp = 0; while (cond) { __builtin_amdgcn_s_sleep(1); \
    if ((++_sp & 255u) == 0u) { if (xb_ld(&(bar)[XB_TMO])) break; if (_sp > XB_SPIN_CAP) { atomicAdd(&(bar)[XB_TMO], 1u); break; } } } } while (0)
struct XcdBarrier { unsigned* bar; unsigned x; volatile LAS unsigned* st; };
DI XcdBarrier xcd_barrier_post(unsigned* bar, volatile LAS unsigned* st) {
    XcdBarrier b; b.bar = bar; b.x = xb_xcc_id(); b.st = st;
    if (threadIdx.x == 0) (void)xb_add(&bar[XB_XCNT(b.x)], 1u);
    return b;
}
DI void xcd_barrier_complete(unsigned* bar, unsigned x, unsigned& nloc, unsigned& nx) {
    const unsigned G = gridDim.x * gridDim.y * gridDim.z;
    unsigned sum, cnt, mine, sp = 0u;
    for (;;) {
        sum = 0u; cnt = 0u; mine = 0u;
#pragma unroll
        for (unsigned j = 0; j < 16; ++j) { const unsigned c = xb_ld(&bar[XB_XCNT(j)]); sum += c; cnt += (c > 0u) ? 1u : 0u; mine = (j == x) ? c : mine; }
        if (sum == G) break;
        __builtin_amdgcn_s_sleep(1);
        if ((++sp & 255u) == 0u) { if (xb_ld(&bar[XB_TMO])) break; if (sp > XB_SPIN_CAP) { atomicAdd(&bar[XB_TMO], 1u); break; } }
    }
    nloc = mine > 0u ? mine : 1u; nx = cnt > 0u ? cnt : 1u;
}
DI void xcd_barrier(const XcdBarrier& b) {
    asm volatile("s_waitcnt vmcnt(0)" ::: "memory");
    __syncthreads();
    if (threadIdx.x == 0) {
        unsigned* bar = b.bar;
        __builtin_amdgcn_s_waitcnt(0);
        unsigned nloc = b.st[0], nx = b.st[1];
        if (nloc == 0u) { xcd_barrier_complete(bar, b.x, nloc, nx); b.st[0] = nloc; b.st[1] = nx; }
        const unsigned old = xb_add(&bar[XB_XSUB(b.x)], 1u);
        const unsigned gen = old / nloc;
        if (old + 1u == (gen + 1u) * nloc) {
            __builtin_amdgcn_fence(__ATOMIC_RELEASE, "agent");
            asm volatile("s_waitcnt vmcnt(0)" ::: "memory");
            const unsigned og = xb_add(&bar[XB_TOP], 1u);
            const unsigned tg = og / nx;
            if (og + 1u == (tg + 1u) * nx) xb_add(&bar[XB_TOPGEN], 1u);
            else XB_SPIN(xb_ld(&bar[XB_TOPGEN]) == tg, bar);
            __builtin_amdgcn_fence(__ATOMIC_ACQUIRE, "agent");
            xb_add(&bar[XB_XGEN(b.x)], 1u);
            asm volatile("s_waitcnt vmcnt(0)" ::: "memory");
        } else {
            XB_SPIN(xb_ld(&bar[XB_XGEN(b.x)]) == gen, bar);
            __builtin_amdgcn_fence(__ATOMIC_ACQUIRE, "agent");
            asm volatile("s_waitcnt vmcnt(0)" ::: "memory");
        }
    }
    __syncthreads();
}
#define GSYNC() do { asm volatile("s_waitcnt vmcnt(0)" ::: "memory"); grid.sync(); asm volatile("s_waitcnt vmcnt(0)" ::: "memory"); __syncthreads(); } while (0)
#define CONV_TAIL(nu, first, last) do { const int _r = (nu) % G; \
    if (_r != 0) { if (bx >= _r) conv_items(A, ws, (first), (last), (bx - _r) * 8 + wave, (G - _r) * 8, (LAS float*)(lds + wave * 16384), fresh_tid() & 63, false); } \
    else conv_items(A, ws, (first), (last), gw, NGW, (LAS float*)(lds + wave * 16384), fresh_tid() & 63, false); } while (0)
__global__ void __launch_bounds__(512, 2) mega_fwd(Args A) {
    extern __shared__ __attribute__((aligned(16))) unsigned char lds_raw[];
    LAS unsigned char* lds = (LAS unsigned char*)lds_raw;
    cg::grid_group grid = cg::this_grid();
    const int wave = __builtin_amdgcn_readfirstlane((int)threadIdx.x >> 6);
    const int G = gridDim.x, bx = blockIdx.x, gw = bx * 8 + wave, NGW = G * 8, NGT = G * 512;
    unsigned char* ws = A.ws;
    float* rstd0 = (float*)(ws + WS_RSTD0); float* gpart = (float*)(ws + WS_GPART); float* part = (float*)(ws + WS_PART);
    float* s5a = (float*)(ws + WS_S5A); bf16_t* bbcat = (bf16_t*)(ws + WS_BBCAT); bf16_t* ccat = (bf16_t*)(ws + WS_CCAT); bf16_t* wmb = (bf16_t*)(ws + WS_WMB);
    float* E = (float*)(ws + WS_E);
    bf16_t* Wt_in = (bf16_t*)(ws + WS_WIN); bf16_t* Wt_out = (bf16_t*)(ws + WS_WOUT); bf16_t* Wt_gu0 = (bf16_t*)(ws + WS_WGU0); bf16_t* Wt_d0 = (bf16_t*)(ws + WS_WD0);
    bf16_t* Wt_glu = (bf16_t*)(ws + WS_WGLU); bf16_t* Wt_gu1 = (bf16_t*)(ws + WS_WGU1); bf16_t* Wt_d1 = (bf16_t*)(ws + WS_WD1);
    bf16_t* XB = (bf16_t*)(ws + WS_XB); bf16_t* ACT = (bf16_t*)(ws + WS_R);
    bf16_t* qb = (bf16_t*)(ws + WS_QB); bf16_t* ub = (bf16_t*)(ws + WS_UB); bf16_t* gvb = (bf16_t*)(ws + WS_GVB); bf16_t* kb = (bf16_t*)(ws + WS_KB); bf16_t* vb = (bf16_t*)(ws + WS_VB);
    bf16_t* omix = (bf16_t*)(ws + WS_OMIX); bf16_t* yb = (bf16_t*)(ws + WS_YB);
    if (threadIdx.x < 2) ((volatile LAS unsigned*)(lds + 131072))[threadIdx.x] = 0u;
    __syncthreads();
    const XcdBarrier xbar = xcd_barrier_post((unsigned*)(ws + WS_BAR), (volatile LAS unsigned*)(lds + 131072));
const bool fastbar = (gridDim.x == 256);
#define XSYNC() do { if (fastbar) xcd_barrier(xbar); else GSYNC(); } while (0)
    float* PB = (float*)(ws + WS_PB);
    float* X = A.out;

    for (int rep = 0; rep <= DUP_P0; ++rep) {
        const int tid = fresh_tid(), lane = tid & 63, gt = bx * 512 + tid;
        LAS float* scr = (LAS float*)(lds + wave * 16384);
        conv_items(A, ws, 0, CV_A1, gw, NGW, scr, lane, false);
        for (int row = gw; row < MTOK; row += NGW) {
            const float* xr = row < MP ? A.in[0] + (size_t)row * DM : A.in[1] + (size_t)(row - MP) * DM;
            f32x4 v[8]; float s = 0.f;
#pragma unroll
            for (int j = 0; j < 8; ++j) { v[j] = *(const f32x4*)(xr + (lane + 64 * j) * 4); s += sumsq4(v[j]); }
            s = wave_sum(s);
            if (lane == 0) rstd0[row] = rsqrtf(s * (1.0f / 2048.0f) + RMS_EPS);
#pragma unroll
            for (int j = 0; j < 8; ++j) *(u32x2*)(XB + (size_t)row * DM + (lane + 64 * j) * 4) = pack4(v[j]);
        }
        for (int idx = gt; idx < 8192; idx += NGT) {
            const int g = idx >> 6;
            const float dt = expf(A.in[17][g]), lr = A.in[15][idx], li = A.in[16][idx];
            const float mag = expf(lr * dt); float sn, cs; sincos_f(li * dt, sn, cs);
            const float are = mag * cs, aim = mag * sn, den = lr * lr + li * li, nr = are - 1.0f;
            const float fre = (nr * lr + aim * li) / den, fim = (aim * lr - nr * li) / den;
            const int p = idx & 63;
#pragma unroll
            for (int i = 0; i < 16; ++i) { const float br = A.in[18][(size_t)idx * 16 + i], bi = A.in[19][(size_t)idx * 16 + i];
                bbcat[((size_t)(g * 128 + p)) * 16 + i] = (bf16_t)f2bf(fre * br - fim * bi); bbcat[((size_t)(g * 128 + 64 + p)) * 16 + i] = (bf16_t)f2bf(fre * bi + fim * br); }
            float pr = are, pi = aim;
#pragma unroll
            for (int k = 0; k < 6; ++k) { const float t0 = pr * pr - pi * pi, t1 = 2.0f * pr * pi; pr = t0; pi = t1; }
            s5a[idx] = are; s5a[8192 + idx] = aim; s5a[16384 + idx] = pr; s5a[24576 + idx] = pi;
        }
        for (int idx = gt; idx < 128 * 16 * 64; idx += NGT) {
            const int p = idx & 63, gi = idx >> 6;
            ccat[(size_t)gi * 128 + p] = (bf16_t)f2bf(A.in[20][idx]); ccat[(size_t)gi * 128 + 64 + p] = (bf16_t)f2bf(-A.in[21][idx]);
        }
        for (int idx = gt; idx < 16 * 128 * 128; idx += NGT) {
            const int s = idx & 127, t = (idx >> 7) & 127;
            wmb[idx] = ((t >> 6) >= (s >> 6)) ? (bf16_t)f2bf(A.in[12][idx]) : (bf16_t)0;
        }
    }
    XSYNC();
    {
        pg8::Gemm g{XB, Wt_in, MTOK, DIN0, DM}; pg8::StaticOrder S; S.init(MTOK, DIN0, G, bx);
        EpiIn Ep{rstd0, qb, kb, vb, ub, gvb, gpart, A.out};
        pg8::gemm_phase<EpiIn, pg8::StaticOrder, true, true>(lds, g, S, Ep);
        CONV_TAIL((MTOK / 256) * (DIN0 / 256), CV_A1, CV_A2);
        if (G == 256 && bx >= 212) conv_early(A, ws, (bx - 212) * 8 + wave, 44 * 8, (LAS float*)(lds + wave * 16384), fresh_tid() & 63);
    }
    XSYNC();
    if (G == 256) {
        const int tid = fresh_tid(), lane = tid & 63;
        attn_unit(lds, bx, A, qb, kb, vb, omix, tid, wave, lane);
        if (bx < 32) { attn_unit(lds, 256 + bx, A, qb, kb, vb, omix, tid, wave, lane);
            gm_unit(lds, 1120 + 2 * bx, A, ub, gvb, gpart, wmb, omix, tid, wave, lane); gm_unit(lds, 1121 + 2 * bx, A, ub, gvb, gpart, wmb, omix, tid, wave, lane); }
        else {
#pragma unroll 1
            for (int k = 0; k < 5; ++k) gm_unit(lds, (bx - 32) + 224 * k, A, ub, gvb, gpart, wmb, omix, tid, wave, lane);
            if (bx < 128) gm_unit(lds, 1184 + (bx - 32), A, ub, gvb, gpart, wmb, omix, tid, wave, lane);
        }
    } else
    for (int u = bx; u < 288 + 1280; u += G) {
        const int tid = fresh_tid(), lane = tid & 63;
        if (u < 288) attn_unit(lds, u, A, qb, kb, vb, omix, tid, wave, lane);
        else gm_unit(lds, u - 288, A, ub, gvb, gpart, wmb, omix, tid, wave, lane);
    }
    XSYNC();
    if (G == 256) {
        pg8::Gemm g{omix, Wt_out, MTOK, DM, DM}; EpiRes Ep{A.in[0], A.in[1], X, XB, part, nullptr, 0};
        { pg8::StaticOrder S; S.init(MP, DM, G, bx); pg8::gemm_phase<EpiRes, pg8::StaticOrder, true, true>(lds, g, S, Ep); }
        XSYNC();
        if (bx < 32) { pg8::OneUnit S{32 + (bx >> 3), bx & 7}; pg8::gemm_phase<EpiRes, pg8::OneUnit, true, true>(lds, g, S, Ep); }
        else if (bx < 80) { const int e = bx - 32; pg8::OneUnit S{pg8::early_panel(0, e >> 1), e & 1}; pg8::Gemm g4{XB, Wt_gu0, MTOK, 2 * DFF, DM}; EpiSwiglu<32> E4{part, ACT};
            pg8::gemm_phase<EpiSwiglu<32>, pg8::OneUnit, true, true>(lds, g4, S, E4); }
        else conv_items(A, ws, CV_A2, CV_A4, (bx - 80) * 8 + wave, 176 * 8, (LAS float*)(lds + wave * 16384), fresh_tid() & 63, true);
    } else {
        pg8::Gemm g{omix, Wt_out, MTOK, DM, DM}; pg8::StaticOrder S; S.init(MTOK, DM, G, bx);
        EpiRes Ep{A.in[0], A.in[1], X, XB, part, nullptr, 0};
        pg8::gemm_phase<EpiRes, pg8::StaticOrder, true, true>(lds, g, S, Ep);
        CONV_TAIL((MTOK / 256) * (DM / 256), CV_A2, CV_A3);
    }
    XSYNC();
    {
        pg8::Gemm g{XB, Wt_gu0, MTOK, 2 * DFF, DM}; EpiSwiglu<32> Ep{part, ACT};
        if (G == 256) { pg8::SkipOrder S; S.init(G, bx, 0); pg8::gemm_phase<EpiSwiglu<32>, pg8::SkipOrder, true, true>(lds, g, S, Ep);
            conv_items(A, ws, CV_A4, CV_A5, gw, NGW, (LAS float*)(lds + wave * 16384), fresh_tid() & 63, false); }
        else { pg8::StaticOrder S; S.init(MTOK, 2 * DFF, G, bx); pg8::gemm_phase<EpiSwiglu<32>, pg8::StaticOrder, true, true>(lds, g, S, Ep);
            CONV_TAIL((MTOK / 256) * (2 * DFF / 256), CV_A3, CV_A5); }
    }
    XSYNC();
    {
        pg8::Gemm g{ACT, Wt_d0, MTOK, DM, DFF};
        if (G == 256) { pg8::SplitOrder S; S.init(DFF, bx); EpiRes Ep{X, X + (size_t)MP * DM, X, nullptr, part, PB, DFF / 64};
            pg8::gemm_phase<EpiRes, pg8::SplitOrder, true, true>(lds, g, S, Ep); }
        else { pg8::StaticOrder S; S.init(MTOK, DM, G, bx); EpiRes Ep{X, X + (size_t)MP * DM, X, nullptr, part, nullptr, 0};
            pg8::gemm_phase<EpiRes, pg8::StaticOrder, true, true>(lds, g, S, Ep); }
    }
    XSYNC();
    for (int rep = 0; rep <= DUP_P6; ++rep) {
        const int lane = fresh_tid() & 63;
        if (G == 256 && rep == 0) {
            const int r = gw >> 1, half = gw & 1;
            float* xr = X + (size_t)(MP + r) * DM + half * 1024; float sq = 0.f;
#pragma unroll
            for (int j = 0; j < 4; ++j) { const int col = (lane + 64 * j) * 4; const f32x4 v = *(const f32x4*)(xr + col) + pb_sum(PB, r, half * 1024 + col); *(f32x4*)(xr + col) = v; sq += sumsq4(v); }
            sq = wave_sum(sq);
            if (lane < 16) part[(size_t)(MP + r) * 32 + 2 * lane + half] = lane == 0 ? sq : 0.f;
        }
        LAS unsigned char* wl = lds + wave * 16384;
        { const int per = (128 * 128 + NGW - 1) / NGW; int prev = -1;
          for (int k = 0; k < per; ++k) { const int it = gw * per + k; if (it >= 128 * 128) break; const int c = it >> 7;
            s5_item<false>(wl, c, it & 127, c != prev, lane, A, X, part, s5a, bbcat, ccat, E, yb); prev = c; } }
    }
    XSYNC();
    {
        const int tid = fresh_tid();
        const int ch = bx * 32 + tid;
        if (tid < 32 && ch < 8192) {
            const float pre = s5a[16384 + ch], pim = s5a[24576 + ch];
            float sre = 0.f, sim = 0.f; float* Ep = E + (size_t)ch * 2;
#pragma unroll 1
            for (int c0 = 0; c0 < 128; c0 += 32) {
                f32x2 e[32];
#pragma unroll
                for (int k = 0; k < 32; ++k) e[k] = *(const f32x2*)(Ep + (size_t)(c0 + k) * 16384);
#pragma unroll
                for (int k = 0; k < 32; ++k) { *(f32x2*)(Ep + (size_t)(c0 + k) * 16384) = (f32x2){sre, sim};
                    const float nre = pre * sre - pim * sim + e[k].x, nim = pre * sim + pim * sre + e[k].y; sre = nre; sim = nim; }
            }
        }
    }
    XSYNC();
    for (int rep = 0; rep <= DUP_P6; ++rep) {
        const int lane = fresh_tid() & 63;
        LAS unsigned char* wl = lds + wave * 16384;
        { const int per = (144 * 128 + NGW - 1) / NGW; int prev = -1;
          for (int k = 0; k < per; ++k) { const int it = gw * per + k; if (it >= 144 * 128) break; const int c = it >> 7;
            s5_item<true>(wl, c, it & 127, c != prev, lane, A, X, part, s5a, bbcat, ccat, E, yb); prev = c; } }
    }
    XSYNC();
    {
        pg8::Gemm g{yb, Wt_glu, MTOK, 2 * DM, DM}; EpiGlu Ep{X, XB, part};
        if (G == 256) {
            { pg8::StaticOrder S; S.init(MP, 2 * DM, G, bx); pg8::gemm_phase<EpiGlu, pg8::StaticOrder, true, true>(lds, g, S, Ep); }
            XSYNC();
            if (bx < 64) { pg8::OneUnit S{32 + (bx >> 4), bx & 15}; pg8::gemm_phase<EpiGlu, pg8::OneUnit, true, true>(lds, g, S, Ep); }
            else if (bx < 112) { const int e = bx - 64; pg8::OneUnit S{pg8::early_panel(1, e >> 1), e & 1}; pg8::Gemm g8{XB, Wt_gu1, MTOK, 2 * DFF, DM}; EpiSwiglu<64> E8{part, ACT};
                pg8::gemm_phase<EpiSwiglu<64>, pg8::OneUnit, true, true>(lds, g8, S, E8); }
            else conv_items(A, ws, CV_A5, CV_A6, (bx - 112) * 8 + wave, 144 * 8, (LAS float*)(lds + wave * 16384), fresh_tid() & 63, true);
        } else {
            pg8::StaticOrder S; S.init(MTOK, 2 * DM, G, bx); pg8::gemm_phase<EpiGlu, pg8::StaticOrder, true, true>(lds, g, S, Ep);
            CONV_TAIL((MTOK / 256) * (2 * DM / 256), CV_A5, CV_A6);
        }
    }
    XSYNC();
    {
        pg8::Gemm g{XB, Wt_gu1, MTOK, 2 * DFF, DM}; EpiSwiglu<64> Ep{part, ACT};
        if (G == 256) { pg8::SkipOrder S; S.init(G, bx, 1); pg8::gemm_phase<EpiSwiglu<64>, pg8::SkipOrder, true, true>(lds, g, S, Ep);
            conv_items(A, ws, CV_A6, CV_A7, gw, NGW, (LAS float*)(lds + wave * 16384), fresh_tid() & 63, false); }
        else { pg8::StaticOrder S; S.init(MTOK, 2 * DFF, G, bx); pg8::gemm_phase<EpiSwiglu<64>, pg8::StaticOrder, true, true>(lds, g, S, Ep);
            CONV_TAIL((MTOK / 256) * (2 * DFF / 256), CV_A6, CV_A7); }
    }
    XSYNC();
    {
        pg8::Gemm g{ACT, Wt_d1, MTOK, DM, DFF};
        if (G == 256) { pg8::SplitOrder S; S.init(DFF, bx); EpiRes Ep{X, X + (size_t)MP * DM, X, nullptr, part, PB, DFF / 64};
            pg8::gemm_phase<EpiRes, pg8::SplitOrder, true, true>(lds, g, S, Ep); }
        else { pg8::StaticOrder S; S.init(MTOK, DM, G, bx); EpiRes Ep{X, X + (size_t)MP * DM, X, nullptr, part, nullptr, 0};
            pg8::gemm_phase<EpiRes, pg8::StaticOrder, true, true>(lds, g, S, Ep); }
    }
    XSYNC();
    {
        const int lane = fresh_tid() & 63;
        const bool deal = (G == 256);
        const int nrows = deal ? (gw < 1024 ? 1 : 8) : (MTOK - gw + NGW - 1) / NGW;
        for (int k = 0; k < nrows; ++k) {
            const int row = deal ? (gw < 1024 ? MP + gw : (gw - 1024) * 8 + k) : gw + k * NGW;
            float* xr = X + (size_t)row * DM; const float* gf = A.in[8];
            f32x4 v[8]; float s = 0.f;
#pragma unroll
            for (int j = 0; j < 8; ++j) { v[j] = *(const f32x4*)(xr + (lane + 64 * j) * 4); if (G == 256 && row >= MP) v[j] += pb_sum(PB, row - MP, (lane + 64 * j) * 4); s += sumsq4(v[j]); }
            s = wave_sum(s);
            const float rs = rsqrtf(s * (1.0f / 2048.0f) + RMS_EPS);
#pragma unroll
            for (int j = 0; j < 8; ++j) *(f32x4*)(xr + (lane + 64 * j) * 4) = v[j] * rs * *(const f32x4*)(gf + (lane + 64 * j) * 4);
        }
    }
}

extern "C" void kernel_launch(void* const* d_in, const int* in_sizes, int n_in, void* d_out, int out_size, void* d_ws, size_t ws_size, hipStream_t stream) {
    static int grid = 0;
    if (grid == 0) {
        if (n_in != 27 || ws_size < WS_END) { fprintf(stderr, "kernel_launch: need 27 inputs and >= %zu bytes of workspace (got %d, %zu)\n", (size_t)WS_END, n_in, ws_size); grid = -1; return; }
        int dev = 0, cus = 0, per_cu = 0;
        (void)hipGetDevice(&dev); (void)hipDeviceGetAttribute(&cus, hipDeviceAttributeMultiprocessorCount, dev);
        if (hipFuncSetAttribute((const void*)mega_fwd, hipFuncAttributeMaxDynamicSharedMemorySize, LDS_BYTES) != hipSuccess) { fprintf(stderr, "kernel_launch: hipFuncSetAttribute failed\n"); grid = -1; return; }
        if (hipOccupancyMaxActiveBlocksPerMultiprocessor(&per_cu, (const void*)mega_fwd, 512, LDS_BYTES) != hipSuccess || per_cu < 1) { fprintf(stderr, "kernel_launch: occupancy query failed (%d)\n", per_cu); (void)hipGetLastError(); per_cu = 1; }
        grid = cus * 1;
        if (grid > cus * per_cu) grid = cus * per_cu;
    }
    if (grid < 0) return;
    if (hipMemsetAsync((char*)d_ws + WS_BAR, 0, 16384, stream) != hipSuccess) { fprintf(stderr, "kernel_launch: memset of the barrier words failed\n"); return; }
    Args a{};
    for (int i = 0; i < 27; ++i) a.in[i] = (const float*)d_in[i];
    a.out = (float*)d_out; a.ws = (unsigned char*)d_ws;
    void* args[] = {&a};
    hipError_t e = hipLaunchCooperativeKernel((const void*)mega_fwd, dim3(grid), dim3(512), args, LDS_BYTES, stream);
    if (e != hipSuccess) fprintf(stderr, "cooperative launch failed: %s (grid %d)\n", hipGetErrorString(e), grid);
}
```

```cpp
#include <hip/hip_runtime.h>
#include <hip/hip_cooperative_groups.h>
#include <cstdio>
#include <cstdint>
namespace cg = cooperative_groups;
#ifndef DUP_P0
#define DUP_P0 0
#endif
#ifndef DUP_P2
#define DUP_P2 0
#endif
#ifndef DUP_P6
#define DUP_P6 0
#endif

#define LAS __attribute__((address_space(3)))
#define DI __device__ __forceinline__
typedef unsigned short bf16_t;
typedef short bf16x8 __attribute__((ext_vector_type(8)));
typedef float f32x4 __attribute__((ext_vector_type(4)));
typedef float f32x2 __attribute__((ext_vector_type(2)));
typedef unsigned u32x4 __attribute__((ext_vector_type(4)));
typedef unsigned u32x2 __attribute__((ext_vector_type(2)));

constexpr int MTOK = 9216, MP = 8192, DM = 2048, DIN0 = 3328, DFF = 5632;
constexpr float RMS_EPS = 1e-5f;
constexpr size_t MiB = 1u << 20;
constexpr size_t WS_RSTD0 = 0;
constexpr size_t WS_BAR   = 40 * 1024;
constexpr size_t WS_GPART = 64 * 1024;
constexpr size_t WS_PART  = 1 * MiB;
constexpr size_t WS_S5A   = 4 * MiB;
constexpr size_t WS_BBCAT = WS_S5A + 128 * 1024;
constexpr size_t WS_CCAT  = WS_BBCAT + 512 * 1024;
constexpr size_t WS_WMB   = WS_CCAT + 512 * 1024;
constexpr size_t WS_E     = 6 * MiB;
constexpr size_t WS_WIN   = 16 * MiB;
constexpr size_t WS_WOUT  = 29 * MiB;
constexpr size_t WS_WGU0  = 37 * MiB;
constexpr size_t WS_WD0   = 81 * MiB;
constexpr size_t WS_WGLU  = 103 * MiB;
constexpr size_t WS_WGU1  = 119 * MiB;
constexpr size_t WS_WD1   = 163 * MiB;
constexpr size_t WS_XB    = 185 * MiB;
constexpr size_t WS_R     = 221 * MiB;
constexpr size_t WS_QB    = WS_R;
constexpr size_t WS_UB    = WS_R + 18 * MiB;
constexpr size_t WS_GVB   = WS_R + 36 * MiB;
constexpr size_t WS_KB    = WS_R + 54 * MiB;
constexpr size_t WS_VB    = WS_R + 57 * MiB;
constexpr size_t WS_OMIX  = WS_R + 60 * MiB;
constexpr size_t WS_YB    = WS_R;
constexpr size_t WS_PB    = 320 * MiB;
constexpr size_t WS_END   = 384 * MiB;
constexpr size_t O_KP = 18874368, O_VP = 18890752, O_KS = 18907136, O_VS = 19038208, O_GV = 19169280,
                 O_SPR = 20217856, O_SPI = 20226048, O_SSR = 20234240, O_SSI = 20365312;

constexpr int LDS_BYTES = 132096;

#define LDS_WAIT() asm volatile("s_waitcnt lgkmcnt(0)" ::: "memory")
DI unsigned f2bf(float f) { unsigned u = __builtin_bit_cast(unsigned, f); return (u + 0x7fffu + ((u >> 16) & 1u)) >> 16; }
DI float bf2f(unsigned h) { return __builtin_bit_cast(float, h << 16); }
typedef __bf16 bf16x2_t __attribute__((ext_vector_type(2)));
DI unsigned cvt_pk_bf16(float lo, float hi) { const f32x2 v = {lo, hi}; const bf16x2_t b = __builtin_convertvector(v, bf16x2_t); return __builtin_bit_cast(unsigned, b); }
DI u32x4 pack8(f32x4 a, f32x4 b) { u32x4 w; w.x = cvt_pk_bf16(a[0], a[1]); w.y = cvt_pk_bf16(a[2], a[3]); w.z = cvt_pk_bf16(b[0], b[1]); w.w = cvt_pk_bf16(b[2], b[3]); return w; }
DI u32x2 pack4(f32x4 a) { u32x2 w; w.x = cvt_pk_bf16(a[0], a[1]); w.y = cvt_pk_bf16(a[2], a[3]); return w; }
DI f32x2 gelu_pk(f32x2 v) {
    const f32x2 av = __builtin_elementwise_abs(v), d = av * 0.2316418882f + 1.0f;
    f32x2 t; t.x = __builtin_amdgcn_rcpf(d.x); t.y = __builtin_amdgcn_rcpf(d.y);
    f32x2 q = t * 0.5307027145f + (-0.7265760135f); q = q * t + 0.7107068705f; q = q * t + (-0.142248368f); q = q * t + 0.127414796f; q = q * t;
    const f32x2 s = (v * v) * (-0.72134752044f);
    f32x2 e; e.x = __builtin_amdgcn_exp2f(s.x); e.y = __builtin_amdgcn_exp2f(s.y);
    const f32x2 m = v * (q * e), r = v - m;
    f32x2 o; o.x = v.x < 0.f ? m.x : r.x; o.y = v.y < 0.f ? m.y : r.y; return o;
}
DI f32x4 gelu4(f32x4 v) { f32x2 a = gelu_pk((f32x2){v[0], v[1]}), b = gelu_pk((f32x2){v[2], v[3]}); return (f32x4){a.x, a.y, b.x, b.y}; }
DI float sigmoidf_(float x) { return __builtin_amdgcn_rcpf(1.0f + __expf(-x)); }
DI float sumsq4(f32x4 v) { return (v[0] * v[0] + v[1] * v[1]) + (v[2] * v[2] + v[3] * v[3]); }

namespace pg8 {
constexpr int BM = 256, BK = 64, HALF = 128, HTB = HALF * BK * 2, STAGE_BYTES = 8 * HTB, NXCD = 8, WGM = 8;
__host__ __device__ __forceinline__ int lds_byte(int r, int c) { const int st = (r >> 4) * 2 + (c >> 5), rr = r & 15, cc = c & 31, ob = rr * 64 + cc * 2; return st * 1024 + (ob ^ (((ob >> 9) & 1) << 5)); }
__host__ __device__ __forceinline__ void stage_rc(int b, int& R, int& C) { const int st = b / 1024, sb = b % 1024, swz = sb ^ (((sb >> 9) & 1) << 5); R = (st >> 1) * 16 + swz / 64; C = (st & 1) * 32 + (swz % 64) / 2; }
__host__ __device__ __forceinline__ int perm32(int rho) { const int n = rho >> 4, i = rho & 15; return 8 * (i >> 2) + 4 * n + (i & 3); }
struct Unit { int pm, pn, k0, nkt, aux; };
struct Gemm { const bf16_t* A; const bf16_t* Bt; int M, N, K; };
struct StaticOrder {
    static constexpr bool VARK = false;
    int nM, nN, nwg, G, c;
    __host__ __device__ void init(int M, int N, int G_, int c_) { nM = M / BM; nN = N / BM; nwg = nM * nN; G = G_; c = c_; }
    __host__ __device__ bool next(int i, Unit& u) const {
        const long L = (long)i * G + c; if (L >= nwg) return false;
        int wgid = (int)L; { const int q = nwg / NXCD, r = nwg % NXCD, xcd = wgid % NXCD, off = wgid / NXCD; wgid = (xcd < r ? xcd * (q + 1) : r * (q + 1) + (xcd - r) * q) + off; }
        const int nig = WGM * nN, gid = wgid / nig, fm = gid * WGM, gsz = (nM - fm) < WGM ? (nM - fm) : WGM;
        u.pm = fm + ((wgid % nig) % gsz); u.pn = (wgid % nig) / gsz; u.k0 = 0; u.nkt = 0; u.aux = 0; return true;
    }
    __device__ __forceinline__ void a_ready(const Unit&) const {}
    __device__ __forceinline__ void done(const Unit&) const {}
};
struct SplitOrder {
    static constexpr bool VARK = true;
    StaticOrder so; int c, nkt_full;
    __host__ __device__ void init(int K, int c_) { so.init(8192, 2048, 256, c_); c = c_; nkt_full = K / BK; }
    __host__ __device__ bool next(int i, Unit& u) const {
        if (i == 0) { so.next(0, u); u.k0 = 0; u.nkt = nkt_full; u.aux = 0; return true; }
        if (i == 1) { const int su = c >> 3, pc = c & 7; u.pm = 32 + (su >> 3); u.pn = su & 7; u.aux = c;
            const int npair = nkt_full / 2, base = npair / 8, rem = npair % 8;
            const int p0 = pc < rem ? pc * (base + 1) : rem * (base + 1) + (pc - rem) * base, np = pc < rem ? base + 1 : base;
            u.k0 = 2 * p0; u.nkt = 2 * np; return true; }
        return false;
    }
    __device__ __forceinline__ void a_ready(const Unit&) const {}
    __device__ __forceinline__ void done(const Unit&) const {}
};
struct OneUnit {
    static constexpr bool VARK = false;
    int pm, pn;
    __device__ __forceinline__ bool next(int i, Unit& u) const { if (i != 0) return false; u.pm = pm; u.pn = pn; u.k0 = 0; u.nkt = 0; u.aux = 0; return true; }
    __device__ __forceinline__ void a_ready(const Unit&) const {}
    __device__ __forceinline__ void done(const Unit&) const {}
};
__host__ __device__ __forceinline__ int early_panel(int lay, int e) { return (lay == 0 || e < 11) ? e : e + 3; }
__host__ __device__ __forceinline__ int late_panel(int lay, int q) { return (lay == 0 || q >= 3) ? 24 + q : 11 + q; }
struct SkipOrder {
    static constexpr bool VARK = false;
    StaticOrder so; int G, c, lay;
    __host__ __device__ void init(int G_, int c_, int lay_) { so.init(36 * 256, 42 * 256, G_, c_); G = G_; c = c_; lay = lay_; }
    __host__ __device__ bool next(int i, Unit& u) const {
        if (so.next(i, u)) { u.pn += 2; return true; }
        const long L = (long)i * G + c - so.nwg; if (L < 0 || L >= 24) return false;
        u.pm = late_panel(lay, (int)(L >> 1)); u.pn = (int)(L & 1); u.k0 = 0; u.nkt = 0; u.aux = 0; return true;
    }
    __device__ __forceinline__ void a_ready(const Unit&) const {}
    __device__ __forceinline__ void done(const Unit&) const {}
};
template <class Epi, class Sched, bool ALIGN_EPI = false, bool SP2 = false>
__device__ __forceinline__ void gemm_phase(LAS unsigned char* lds, const Gemm g, const Sched& S, const Epi& E) {
    const int tid = threadIdx.x, wid = __builtin_amdgcn_readfirstlane(tid >> 6), lane = tid & 63, wr = wid >> 2, wc = wid & 3, fr = lane & 15, fq = lane >> 4;
    const int K = g.K, nt = K / BK;
    unsigned voffA[2], voffB[2];
#pragma unroll
    for (int i = 0; i < 2; ++i) { int R, C; stage_rc(tid * 16 + i * 8192, R, C); const int Rb = Epi::PERM ? ((R & ~31) + perm32(R & 31)) : R;
        voffA[i] = (unsigned)(R * K + C) * 2u; voffB[i] = (unsigned)(Rb * K + C) * 2u; }
    const size_t kstep = (size_t)(BK * 2);
    const size_t hstep = (size_t)HALF * K * 2;
    const size_t tstep = 2 * hstep;
    const unsigned ldsw = (unsigned)wid * 1024u;
    const int aoff = lds_byte(wr * 64 + fr, fq * 8), boff = lds_byte(wc * 32 + fr, fq * 8);
#define PG8_SA(b, h) (((b) * 2 + (h)) * HTB)
#define PG8_SB(b, h) ((4 + (b) * 2 + (h)) * HTB)
#define PG8_STAGE(bufoff, gbase, voff) do { _Pragma("unroll") for (int _i = 0; _i < 2; ++_i) \
        __builtin_amdgcn_global_load_lds((const unsigned*)((const char*)(gbase) + (voff)[_i]), (LAS unsigned*)(lds + (bufoff) + ldsw + _i * 8192), 16, 0, 0); } while (0)
#define PG8_LDA(dst, b, h) do { _Pragma("unroll") for (int m = 0; m < 4; ++m) _Pragma("unroll") for (int k = 0; k < 2; ++k) dst[m][k] = *(const LAS bf16x8*)(lds + PG8_SA(b, h) + aoff + m * 2048 + k * 1024); } while (0)
#define PG8_LDB(dst, b, h) do { _Pragma("unroll") for (int n = 0; n < 2; ++n) _Pragma("unroll") for (int k = 0; k < 2; ++k) dst[n][k] = *(const LAS bf16x8*)(lds + PG8_SB(b, h) + boff + n * 2048 + k * 1024); } while (0)
#define PG8_MMA(ai, bj, At, Bt) do { __builtin_amdgcn_s_setprio(1); _Pragma("unroll") for (int m = 0; m < 4; ++m) _Pragma("unroll") for (int n = 0; n < 2; ++n) _Pragma("unroll") for (int k = 0; k < 2; ++k) \
        acc[ai][bj][m][n] = __builtin_amdgcn_mfma_f32_16x16x32_bf16(Bt[n][k], At[m][k], acc[ai][bj][m][n], 0, 0, 0); __builtin_amdgcn_s_setprio(0); } while (0)
#define PG8_WAIT_V(n) asm volatile("s_waitcnt vmcnt(" #n ")" ::: "memory")
#define PG8_WAIT_L(n) asm volatile("s_waitcnt lgkmcnt(" #n ")" ::: "memory")
#define PG8_BAR __builtin_amdgcn_s_barrier()
#define PG8_SCHED __builtin_amdgcn_sched_barrier(0)
    Unit cur, nxt; int ui = 0;
    if (!S.next(0, cur)) return;
    f32x4 acc[2][2][4][2];
#pragma unroll
    for (int a = 0; a < 2; ++a)
#pragma unroll
        for (int b = 0; b < 2; ++b)
#pragma unroll
            for (int m = 0; m < 4; ++m)
#pragma unroll
                for (int n = 0; n < 2; ++n) acc[a][b][m][n] = (f32x4){0.f, 0.f, 0.f, 0.f};
    bf16x8 At[4][2], B0[2][2], B1[2][2];
    const char* cA = (const char*)g.A + (size_t)cur.pm * tstep; const char* cB = (const char*)g.Bt + (size_t)cur.pn * tstep;
    if constexpr (Sched::VARK) { cA += (size_t)cur.k0 * kstep; cB += (size_t)cur.k0 * kstep; }
    S.a_ready(cur);
    if constexpr (SP2) {
        PG8_STAGE(PG8_SB(0, 0), cB, voffB); PG8_STAGE(PG8_SB(0, 1), cB + hstep, voffB); PG8_STAGE(PG8_SA(0, 0), cA, voffA); PG8_STAGE(PG8_SA(0, 1), cA + hstep, voffA);
        if (wr == 1) PG8_BAR;
        PG8_WAIT_V(2); PG8_BAR;
        PG8_STAGE(PG8_SB(1, 0), cB + kstep, voffB); PG8_STAGE(PG8_SA(1, 0), cA + kstep, voffA); PG8_STAGE(PG8_SB(1, 1), cB + hstep + kstep, voffB);
        PG8_WAIT_V(6); PG8_BAR;
    } else {
        PG8_STAGE(PG8_SB(0, 0), cB, voffB); PG8_STAGE(PG8_SA(0, 0), cA, voffA); PG8_STAGE(PG8_SB(0, 1), cB + hstep, voffB); PG8_STAGE(PG8_SA(0, 1), cA + hstep, voffA);
        if (wr == 1) PG8_BAR;
        PG8_WAIT_V(4); PG8_BAR;
        PG8_STAGE(PG8_SB(1, 0), cB + kstep, voffB); PG8_STAGE(PG8_SA(1, 0), cA + kstep, voffA); PG8_STAGE(PG8_SB(1, 1), cB + hstep + kstep, voffB);
        PG8_WAIT_V(6); PG8_BAR;
    }
    for (;;) {
        const bool has_next = S.next(ui + 1, nxt);
        const char* nA = has_next ? (const char*)g.A + (size_t)nxt.pm * tstep : cA; const char* nB = has_next ? (const char*)g.Bt + (size_t)nxt.pn * tstep : cB;
        if constexpr (Sched::VARK) { if (has_next) { nA += (size_t)nxt.k0 * kstep; nB += (size_t)nxt.k0 * kstep; } }
        const int cnt = Sched::VARK ? cur.nkt : nt;
        for (int t = 0; t < cnt; t += 2) {
            const bool last = (t == cnt - 2);
            const char* a1 = cA + (size_t)(t + 1) * kstep;
            const char* a2 = last ? nA : cA + (size_t)(t + 2) * kstep; const char* b2 = last ? nB : cB + (size_t)(t + 2) * kstep;
            const char* a3 = a2 + kstep; const char* b3 = b2 + kstep;
            if (last && has_next) S.a_ready(nxt);
            if constexpr (SP2) {
            PG8_LDB(B0, 0, 0); PG8_LDB(B1, 0, 1); PG8_SCHED; PG8_LDA(At, 0, 0); PG8_STAGE(PG8_SA(1, 1), a1 + hstep, voffA);
            PG8_WAIT_V(8); PG8_WAIT_L(0); PG8_BAR; PG8_MMA(0, 0, At, B0); PG8_MMA(0, 1, At, B1); PG8_BAR; PG8_SCHED;
            PG8_LDA(At, 0, 1); PG8_STAGE(PG8_SB(0, 0), b2, voffB); PG8_STAGE(PG8_SB(0, 1), b2 + hstep, voffB); PG8_STAGE(PG8_SA(0, 0), a2, voffA);
            PG8_WAIT_V(8); PG8_WAIT_L(0); PG8_BAR; PG8_MMA(1, 0, At, B0); PG8_MMA(1, 1, At, B1); PG8_BAR; PG8_SCHED;
            PG8_LDB(B0, 1, 0); PG8_LDB(B1, 1, 1); PG8_SCHED; PG8_LDA(At, 1, 0); PG8_STAGE(PG8_SA(0, 1), a2 + hstep, voffA);
            PG8_WAIT_V(8); PG8_WAIT_L(0); PG8_BAR; PG8_MMA(0, 0, At, B0); PG8_MMA(0, 1, At, B1); PG8_BAR; PG8_SCHED;
            PG8_LDA(At, 1, 1); PG8_STAGE(PG8_SB(1, 0), b3, voffB); PG8_STAGE(PG8_SB(1, 1), b3 + hstep, voffB); PG8_STAGE(PG8_SA(1, 0), a3, voffA);
            PG8_WAIT_V(8); PG8_WAIT_L(0); PG8_BAR; PG8_MMA(1, 0, At, B0); PG8_MMA(1, 1, At, B1); PG8_BAR; PG8_SCHED;
            } else {
            PG8_LDB(B0, 0, 0); PG8_SCHED; PG8_LDA(At, 0, 0); PG8_STAGE(PG8_SA(1, 1), a1 + hstep, voffA);
            PG8_WAIT_L(8); PG8_BAR; PG8_WAIT_L(0); PG8_MMA(0, 0, At, B0); PG8_BAR; PG8_SCHED;
            PG8_LDB(B1, 0, 1); PG8_STAGE(PG8_SB(0, 0), b2, voffB);
            PG8_BAR; PG8_WAIT_L(0); PG8_MMA(0, 1, At, B1); PG8_BAR;
            PG8_LDA(At, 0, 1); PG8_STAGE(PG8_SA(0, 0), a2, voffA);
            PG8_BAR; PG8_WAIT_L(0); PG8_MMA(1, 0, At, B0); PG8_BAR; PG8_SCHED;
            PG8_STAGE(PG8_SB(0, 1), b2 + hstep, voffB);
            PG8_WAIT_V(6); PG8_BAR; PG8_MMA(1, 1, At, B1); PG8_BAR;
            PG8_LDB(B0, 1, 0); PG8_SCHED; PG8_LDA(At, 1, 0); PG8_STAGE(PG8_SA(0, 1), a2 + hstep, voffA);
            PG8_WAIT_L(8); PG8_BAR; PG8_WAIT_L(0); PG8_MMA(0, 0, At, B0); PG8_BAR; PG8_SCHED;
            PG8_LDB(B1, 1, 1); PG8_STAGE(PG8_SB(1, 0), b3, voffB);
            PG8_BAR; PG8_WAIT_L(0); PG8_MMA(0, 1, At, B1); PG8_BAR;
            PG8_LDA(At, 1, 1); PG8_STAGE(PG8_SA(1, 0), a3, voffA);
            PG8_BAR; PG8_WAIT_L(0); PG8_MMA(1, 0, At, B0); PG8_BAR; PG8_SCHED;
            PG8_STAGE(PG8_SB(1, 1), b3 + hstep, voffB);
            PG8_WAIT_V(6); PG8_BAR; PG8_MMA(1, 1, At, B1); PG8_BAR;
            }
        }
        if constexpr (ALIGN_EPI) { if (wr == 0) PG8_BAR; }
        E(acc, cur, wr, wc, fr, fq);
        if (!has_next) break;
#pragma unroll
        for (int a = 0; a < 2; ++a)
#pragma unroll
            for (int b = 0; b < 2; ++b)
#pragma unroll
                for (int m = 0; m < 4; ++m)
#pragma unroll
                    for (int n = 0; n < 2; ++n) acc[a][b][m][n] = (f32x4){0.f, 0.f, 0.f, 0.f};
        cur = nxt; cA = nA; cB = nB; ++ui;
        if constexpr (ALIGN_EPI) { if (wr == 1) PG8_BAR; }
    }
    PG8_WAIT_V(0);
    if constexpr (!ALIGN_EPI) { if (wr == 0) PG8_BAR; }
    PG8_BAR;
#undef PG8_SA
#undef PG8_SB
#undef PG8_STAGE
#undef PG8_LDA
#undef PG8_LDB
#undef PG8_MMA
#undef PG8_WAIT_V
#undef PG8_WAIT_L
#undef PG8_BAR
#undef PG8_SCHED
}
}
using pg8::Unit;

template <int NP> DI float row_rstd(const float* part, int row, int fq) {
    const float* p = part + (size_t)row * NP + fq * (NP / 4);
    float s = 0.f;
#pragma unroll
    for (int i = 0; i < NP / 4; i += 4) { const f32x4 v = *(const f32x4*)(p + i); s += (v[0] + v[1]) + (v[2] + v[3]); }
    s += __shfl_xor(s, 16); s += __shfl_xor(s, 32);
    return rsqrtf(s * (1.0f / 2048.0f) + RMS_EPS);
}

struct EpiIn {
    static constexpr bool PERM = true;
    const float* rstd0; bf16_t *qb, *kb, *vb, *ub, *gvb; float* gpart; float* out;
    DI void operator()(const f32x4 (&acc)[2][2][4][2], const Unit& u, int wr, int wc, int fr, int fq) const {
        const int pn = u.pn, rowb = u.pm * 256 + wr * 64 + fr, cw = wc * 32 + 8 * fq;
#pragma unroll
        for (int ai = 0; ai < 2; ++ai)
#pragma unroll
            for (int m = 0; m < 4; ++m) {
                const int row = rowb + ai * 128 + m * 16; const float rs = rstd0[row];
                if (pn < 4) {
#pragma unroll
                    for (int bj = 0; bj < 2; ++bj) *(u32x4*)(qb + (size_t)row * 1024 + pn * 256 + bj * 128 + cw) = pack8(acc[ai][bj][m][0] * rs, acc[ai][bj][m][1] * rs);
                } else if (pn == 4) {
#pragma unroll
                    for (int bj = 0; bj < 2; ++bj) {
                        const f32x4 v0 = acc[ai][bj][m][0] * rs, v1 = acc[ai][bj][m][1] * rs;
                        *(u32x4*)((bj ? vb : kb) + (size_t)row * 128 + cw) = pack8(v0, v1);
                        float* o = nullptr;
                        if (row >= MP) o = out + (bj ? O_VS : O_KS) + (size_t)(row - MP) * 128 + cw;
                        else if (row >= MP - 128) o = out + (bj ? O_VP : O_KP) + (size_t)(row - (MP - 128)) * 128 + cw;
                        if (o) { *(f32x4*)o = v0; *(f32x4*)(o + 4) = v1; }
                    }
                } else if (pn < 9) {
#pragma unroll
                    for (int bj = 0; bj < 2; ++bj) *(u32x4*)(ub + (size_t)row * 1024 + (pn - 5) * 256 + bj * 128 + cw) = pack8(gelu4(acc[ai][bj][m][0] * rs), gelu4(acc[ai][bj][m][1] * rs));
                } else {
                    float q = 0.f;
#pragma unroll
                    for (int bj = 0; bj < 2; ++bj) { const f32x4 v0 = gelu4(acc[ai][bj][m][0] * rs), v1 = gelu4(acc[ai][bj][m][1] * rs); q += sumsq4(v0) + sumsq4(v1);
                        *(u32x4*)(gvb + (size_t)row * 1024 + (pn - 9) * 256 + bj * 128 + cw) = pack8(v0, v1); }
                    q += __shfl_xor(q, 16); q += __shfl_xor(q, 32);
                    if (fq == 0) gpart[(size_t)row * 16 + (pn - 9) * 4 + wc] = q;
                }
            }
    }
};
struct EpiRes {
    static constexpr bool PERM = true;
    const float* base_p; const float* base_s; float* X; bf16_t* xb; float* part; float* pb; int nkt_full;
    DI void operator()(const f32x4 (&acc)[2][2][4][2], const Unit& u, int wr, int wc, int fr, int fq) const {
        if (pb && u.nkt != nkt_full) {
            float* t = pb + (size_t)u.aux * 65536 + (size_t)(wr * 64 + fr) * 256 + wc * 32 + 8 * fq;
#pragma unroll
            for (int ai = 0; ai < 2; ++ai)
#pragma unroll
                for (int m = 0; m < 4; ++m)
#pragma unroll
                    for (int bj = 0; bj < 2; ++bj) { float* o = t + (ai * 128 + m * 16) * 256 + bj * 128; *(f32x4*)o = acc[ai][bj][m][0]; *(f32x4*)(o + 4) = acc[ai][bj][m][1]; }
            return;
        }
        const int rowb = u.pm * 256 + wr * 64 + fr, cw = u.pn * 256 + wc * 32 + 8 * fq;
#pragma unroll
        for (int ai = 0; ai < 2; ++ai)
#pragma unroll
            for (int m = 0; m < 4; ++m) {
                const int row = rowb + ai * 128 + m * 16;
                const float* b = row < MP ? base_p + (size_t)row * DM : base_s + (size_t)(row - MP) * DM;
                float q = 0.f;
#pragma unroll
                for (int bj = 0; bj < 2; ++bj) { const int col = cw + bj * 128;
                    const f32x4 v0 = acc[ai][bj][m][0] + *(const f32x4*)(b + col), v1 = acc[ai][bj][m][1] + *(const f32x4*)(b + col + 4);
                    *(f32x4*)(X + (size_t)row * DM + col) = v0; *(f32x4*)(X + (size_t)row * DM + col + 4) = v1;
                    if (xb) *(u32x4*)(xb + (size_t)row * DM + col) = pack8(v0, v1);
                    q += sumsq4(v0) + sumsq4(v1); }
                q += __shfl_xor(q, 16); q += __shfl_xor(q, 32);
                if (fq == 0) part[(size_t)row * 32 + u.pn * 4 + wc] = q;
            }
    }
};
template <int NP> struct EpiSwiglu {
    static constexpr bool PERM = true;
    const float* part; bf16_t* act;
    DI void operator()(const f32x4 (&acc)[2][2][4][2], const Unit& u, int wr, int wc, int fr, int fq) const {
        const int rowb = u.pm * 256 + wr * 64 + fr, col = u.pn * 128 + wc * 32 + 8 * fq;
#pragma unroll
        for (int ai = 0; ai < 2; ++ai)
#pragma unroll
            for (int m = 0; m < 4; ++m) {
                const int row = rowb + ai * 128 + m * 16; const float rs = row_rstd<NP>(part, row, fq);
                const float rs2 = rs * rs, nk = -1.4426950408889634f * rs;
                f32x4 o[2];
#pragma unroll
                for (int n = 0; n < 2; ++n) { const f32x4 ga = acc[ai][0][m][n], ua = acc[ai][1][m][n];
                    const f32x4 t = ga * nk; f32x4 d, r;
#pragma unroll
                    for (int e = 0; e < 4; ++e) d[e] = __builtin_amdgcn_exp2f(t[e]);
                    d = d + 1.0f;
#pragma unroll
                    for (int e = 0; e < 4; ++e) r[e] = __builtin_amdgcn_rcpf(d[e]);
                    o[n] = ((ga * ua) * rs2) * r; }
                *(u32x4*)(act + (size_t)row * DFF + col) = pack8(o[0], o[1]);
            }
    }
};
struct EpiGlu {
    static constexpr bool PERM = true;
    float* X; bf16_t* xb; float* part;
    DI void operator()(const f32x4 (&acc)[2][2][4][2], const Unit& u, int wr, int wc, int fr, int fq) const {
        const int rowb = u.pm * 256 + wr * 64 + fr, col = u.pn * 128 + wc * 32 + 8 * fq;
#pragma unroll
        for (int ai = 0; ai < 2; ++ai)
#pragma unroll
            for (int m = 0; m < 4; ++m) {
                const int row = rowb + ai * 128 + m * 16; float* xp = X + (size_t)row * DM + col;
                f32x4 o[2];
#pragma unroll
                for (int n = 0; n < 2; ++n) { const f32x4 v = acc[ai][0][m][n], g = acc[ai][1][m][n]; const f32x4 b = *(const f32x4*)(xp + 4 * n);
#pragma unroll
                    for (int e = 0; e < 4; ++e) o[n][e] = b[e] + v[e] * sigmoidf_(g[e]); }
                *(f32x4*)xp = o[0]; *(f32x4*)(xp + 4) = o[1];
                *(u32x4*)(xb + (size_t)row * DM + col) = pack8(o[0], o[1]);
                float q = sumsq4(o[0]) + sumsq4(o[1]);
                q += __shfl_xor(q, 16); q += __shfl_xor(q, 32);
                if (fq == 0) part[(size_t)row * 64 + u.pn * 4 + wc] = q;
            }
    }
};

DI int fresh_tid() { int t; asm volatile("v_mov_b32 %0, %1" : "=v"(t) : "v"((int)threadIdx.x)); return t; }
struct Args { const float* in[27]; float* out; unsigned char* ws; };

DI float wave_sum(float v) {
#pragma unroll
    for (int o = 1; o < 64; o <<= 1) v += __shfl_xor(v, o);
    return v;
}

DI void tr_item(const float* W, int ldw, int k0, int c0, const float* gk, bf16_t* WT, int K, int drow0, LAS float* scr, int lane) {
    f32x4 v[8];
#pragma unroll
    for (int i = 0; i < 8; ++i) { const int k = 8 * i + (lane >> 3); v[i] = *(const f32x4*)(W + (size_t)(k0 + k) * ldw + c0 + (lane & 7) * 4); }
#pragma unroll
    for (int i = 0; i < 8; ++i) { const int k = 8 * i + (lane >> 3); const float sc = gk ? gk[k0 + k] : 1.0f; LAS float* d = scr + k * 33 + (lane & 7) * 4;
        d[0] = v[i][0] * sc; d[1] = v[i][1] * sc; d[2] = v[i][2] * sc; d[3] = v[i][3] * sc; }
    LDS_WAIT(); asm volatile("" ::: "memory");
    const int c = lane & 7;
#pragma unroll
    for (int j = 0; j < 4; ++j) { const int n = (lane >> 3) + 8 * j; const LAS float* s = scr + (8 * c) * 33 + n;
        u32x4 o; o.x = cvt_pk_bf16(s[0 * 33], s[1 * 33]); o.y = cvt_pk_bf16(s[2 * 33], s[3 * 33]); o.z = cvt_pk_bf16(s[4 * 33], s[5 * 33]); o.w = cvt_pk_bf16(s[6 * 33], s[7 * 33]);
        *(u32x4*)(WT + (size_t)(drow0 + n) * K + k0 + 8 * c) = o; }
    LDS_WAIT(); asm volatile("" ::: "memory");
}
DI void tr_mat(const float* W, int ldw, int csrc, int K, int N, const float* gk, bf16_t* WT, int inter, int half, LAS float* scr, int r, int lane) {
    const int nblk = N / 32, kb = r / nblk, nb = r % nblk, n0 = 32 * nb;
    const int drow0 = inter ? ((n0 >> 7) * 256 + half * 128 + (n0 & 127)) : n0;
    tr_item(W, ldw, 64 * kb, csrc + n0, gk, WT, K, drow0, scr, lane);
}

DI void sincos_f(float x, float& s, float& c) {
    const float n = rintf(x * 0.636619772367581343f);
    float r = fmaf(-n, 1.5703125f, x); r = fmaf(-n, 4.837512969970703125e-4f, r); r = fmaf(-n, 7.54978995489188216e-8f, r);
    const float z = r * r;
    const float sp = r + r * z * (-1.6666654611e-1f + z * (8.3321608736e-3f + z * (-1.9515295891e-4f)));
    const float cp = 1.0f - 0.5f * z + z * z * (4.166664568298827e-2f + z * (-1.388731625493765e-3f + z * 2.443315711809948e-5f));
    const int q = ((int)n) & 3;
    const float ss = (q & 1) ? cp : sp, cc = (q & 1) ? sp : cp;
    s = (q & 2) ? -ss : ss; c = ((q + 1) & 2) ? -cc : cc;
}

DI void attn_unit(LAS unsigned char* lds, int unit, const Args& A, const bf16_t* qb, const bf16_t* kb, const bf16_t* vb, bf16_t* omix, int tid, int wave, int lane) {
    LAS bf16_t* Ks = (LAS bf16_t*)lds;
    LAS bf16_t* Vt = (LAS bf16_t*)(lds + 27648);
    const int kh = unit & 1, cidx = unit >> 1; const bool samp = cidx >= 128; const int bs = cidx - 128;
    const float* ck = A.in[2]; const float* cv = A.in[3];
#pragma unroll
    for (int r = 0; r < 3; ++r) {
        const int idx = tid + 512 * r, key = idx >> 3, db = idx & 7;
        u32x4 kk = (u32x4){0u, 0u, 0u, 0u}, vv = (u32x4){0u, 0u, 0u, 0u};
        if (samp && key < 128) {
            const size_t o = ((size_t)(bs * 128 + key) * 2 + kh) * 64 + db * 8;
            kk = pack8(*(const f32x4*)(ck + o), *(const f32x4*)(ck + o + 4)); vv = pack8(*(const f32x4*)(cv + o), *(const f32x4*)(cv + o + 4));
        } else {
            const int row = samp ? (MP + bs * 64 + key - 128) : ((cidx - 2) * 64 + key);
            if (row >= 0) { kk = *(const u32x4*)(kb + (size_t)row * 128 + kh * 64 + db * 8); vv = *(const u32x4*)(vb + (size_t)row * 128 + kh * 64 + db * 8); }
        }
        *(LAS u32x4*)(Ks + key * 72 + db * 8) = kk;
#pragma unroll
        for (int e = 0; e < 4; ++e) { const unsigned w = vv[e]; Vt[(db * 8 + 2 * e) * 200 + key] = (bf16_t)(w & 0xffffu); Vt[(db * 8 + 2 * e + 1) * 200 + key] = (bf16_t)(w >> 16); }
    }
    __syncthreads();
    const int h = kh * 8 + wave, fr = lane & 15, quad = lane >> 4;
    const float slope = exp2f(-0.5f * (float)(h + 1)), sink = A.in[10][h];
    const int rowbase = samp ? (MP + bs * 64) : cidx * 64;
    const int kmin = samp ? 0 : (2 - cidx) * 64;
#pragma unroll 1
    for (int qt = 0; qt < 4; ++qt) {
        const int qrow = rowbase + qt * 16 + fr;
        bf16x8 bq[2];
#pragma unroll
        for (int ks = 0; ks < 2; ++ks) bq[ks] = *(const bf16x8*)(qb + (size_t)qrow * 1024 + h * 64 + ks * 32 + quad * 8);
        f32x4 s[12];
#pragma unroll
        for (int kt = 0; kt < 12; ++kt) { f32x4 a = (f32x4){0.f, 0.f, 0.f, 0.f};
#pragma unroll
            for (int ks = 0; ks < 2; ++ks) { const bf16x8 ak = *(const LAS bf16x8*)(Ks + (kt * 16 + fr) * 72 + ks * 32 + quad * 8); a = __builtin_amdgcn_mfma_f32_16x16x32_bf16(ak, bq[ks], a, 0, 0, 0); }
            s[kt] = a; if (kt & 1) __builtin_amdgcn_sched_barrier(0); }
        const int qi = qt * 16 + fr;
        float mx = -1e30f;
#pragma unroll
        for (int kt = 0; kt < 12; ++kt)
#pragma unroll
            for (int j = 0; j < 4; ++j) { const int ki = kt * 16 + quad * 4 + j; const int d = 128 + qi - ki; const float dist = (float)(d < 0 ? -d : d);
                float v = s[kt][j] * 0.125f - slope * dist; if (ki < kmin) v = -1e30f; s[kt][j] = v; mx = fmaxf(mx, v); }
        mx = fmaxf(mx, __shfl_xor(mx, 16)); mx = fmaxf(mx, __shfl_xor(mx, 32)); mx = fmaxf(mx, sink);
        float sum = 0.f;
#pragma unroll
        for (int kt = 0; kt < 12; ++kt)
#pragma unroll
            for (int j = 0; j < 4; ++j) { const float p = __expf(s[kt][j] - mx); s[kt][j] = p; sum += p; }
        sum += __shfl_xor(sum, 16); sum += __shfl_xor(sum, 32);
        const float inv = 1.0f / (sum + __expf(sink - mx));
        f32x4 o[4];
#pragma unroll
        for (int dt = 0; dt < 4; ++dt) o[dt] = (f32x4){0.f, 0.f, 0.f, 0.f};
#pragma unroll
        for (int s2 = 0; s2 < 6; ++s2) {
            const u32x4 bpw = pack8(s[2 * s2] * inv, s[2 * s2 + 1] * inv); const bf16x8 bp = __builtin_bit_cast(bf16x8, bpw);
#pragma unroll
            for (int dt = 0; dt < 4; ++dt) {
                const LAS bf16_t* vp = Vt + (dt * 16 + fr) * 200 + s2 * 32 + quad * 4;
                const u32x2 lo = *(const LAS u32x2*)vp, hi = *(const LAS u32x2*)(vp + 16);
                const u32x4 avw = (u32x4){lo.x, lo.y, hi.x, hi.y};
                o[dt] = __builtin_amdgcn_mfma_f32_16x16x32_bf16(__builtin_bit_cast(bf16x8, avw), bp, o[dt], 0, 0, 0);
            }
            __builtin_amdgcn_sched_barrier(0);
        }
#pragma unroll
        for (int dt = 0; dt < 4; ++dt) *(u32x2*)(omix + (size_t)qrow * DM + h * 64 + dt * 16 + quad * 4) = pack4(o[dt]);
    }
    __syncthreads();
}

DI void gm_unit(LAS unsigned char* lds, int unit, const Args& A, const bf16_t* ub, const bf16_t* gvb, const float* gpart, const bf16_t* wmb, bf16_t* omix, int tid, int wave, int lane) {
    LAS bf16_t* vT = (LAS bf16_t*)lds;
    const bool samp = unit >= 1024; const int g = unit & 15;
    const int r0 = samp ? (MP + ((unit - 1024) >> 4) * 64) : ((unit >> 4) * 128), T = samp ? 64 : 128;
    {
        const int s = tid >> 2, dq = tid & 3;
        if (s < T) {
            const int row = r0 + s;
            const f32x4 pp = *(const f32x4*)(gpart + (size_t)row * 16 + dq * 4);
            float ss = (pp[0] + pp[1]) + (pp[2] + pp[3]); ss += __shfl_xor(ss, 1); ss += __shfl_xor(ss, 2);
            const float rs = rsqrtf(ss * (1.0f / 1024.0f) + RMS_EPS);
            const int c0 = g * 64 + dq * 16;
            const u32x4 w0 = *(const u32x4*)(gvb + (size_t)row * 1024 + c0), w1 = *(const u32x4*)(gvb + (size_t)row * 1024 + c0 + 8);
            const float* gn = A.in[11] + c0;
            float val[16];
#pragma unroll
            for (int e = 0; e < 4; ++e) { val[2 * e] = bf2f(w0[e] & 0xffffu); val[2 * e + 1] = bf2f(w0[e] >> 16); val[8 + 2 * e] = bf2f(w1[e] & 0xffffu); val[8 + 2 * e + 1] = bf2f(w1[e] >> 16); }
#pragma unroll
            for (int e = 0; e < 16; ++e) val[e] = val[e] * rs * gn[e];
            if (samp) { float* o = A.out + O_GV + (size_t)(row - MP) * 1024 + c0;
#pragma unroll
                for (int e = 0; e < 4; ++e) *(f32x4*)(o + 4 * e) = (f32x4){val[4 * e], val[4 * e + 1], val[4 * e + 2], val[4 * e + 3]}; }
#pragma unroll
            for (int e = 0; e < 16; ++e) vT[(dq * 16 + e) * 136 + s] = (bf16_t)f2bf(val[e]);
        }
    }
    __syncthreads();
    const int tt = wave, fr = lane & 15, quad = lane >> 4;
    if (tt * 16 < T) {
        const int t = tt * 16 + fr, row = r0 + t;
        const bool lowhalf = tt < 4;
        bf16x8 bw[4];
#pragma unroll
        for (int ks = 0; ks < 4; ++ks) bw[ks] = (ks < 2 || !lowhalf) ? *(const bf16x8*)(wmb + ((size_t)(g * 128 + t)) * 128 + ks * 32 + quad * 8) : (bf16x8){0, 0, 0, 0, 0, 0, 0, 0};
        const float bias = A.in[13][g * 128 + t];
#pragma unroll
        for (int dt = 0; dt < 4; ++dt) {
            f32x4 acc = (f32x4){0.f, 0.f, 0.f, 0.f};
#pragma unroll
            for (int ks = 0; ks < 4; ++ks) if (ks < 2 || !lowhalf) {
                const bf16x8 a = *(const LAS bf16x8*)(vT + (dt * 16 + fr) * 136 + ks * 32 + quad * 8);
                acc = __builtin_amdgcn_mfma_f32_16x16x32_bf16(a, bw[ks], acc, 0, 0, 0); }
            const int c = g * 64 + dt * 16 + quad * 4;
            const u32x2 uw = *(const u32x2*)(ub + (size_t)row * 1024 + c);
            f32x4 o; o[0] = bf2f(uw.x & 0xffffu) * (acc[0] + bias); o[1] = bf2f(uw.x >> 16) * (acc[1] + bias); o[2] = bf2f(uw.y & 0xffffu) * (acc[2] + bias); o[3] = bf2f(uw.y >> 16) * (acc[3] + bias);
            *(u32x2*)(omix + (size_t)row * DM + 1024 + c) = pack4(o);
        }
    }
    __syncthreads();
}

template <bool FULL> DI void s5_item(LAS unsigned char* wl, int cidx, int g, bool newchunk, int lane, const Args& A, const float* X, const float* part, const float* s5a, const bf16_t* bbcat, const bf16_t* ccat, float* E, bf16_t* yb) {
    LAS float* bu = (LAS float*)wl;
    LAS bf16_t* sb = (LAS bf16_t*)(wl + 8448);
    LAS float* rsl = (LAS float*)(wl + 8448 + 4352);
    const bool samp = cidx >= 128; const int rowbase = samp ? MP + (cidx - 128) * 64 : cidx * 64;
    if (newchunk) {
        const float* pp = part + (size_t)(rowbase + lane) * 32; float s = 0.f;
#pragma unroll
        for (int i = 0; i < 32; i += 4) { const f32x4 v = *(const f32x4*)(pp + i); s += (v[0] + v[1]) + (v[2] + v[3]); }
        rsl[lane] = rsqrtf(s * (1.0f / 2048.0f) + RMS_EPS);
    }
    const int fr = lane & 15, quad = lane >> 4;
    const bf16x8 zero8 = (bf16x8){0, 0, 0, 0, 0, 0, 0, 0};
    bf16x8 bbf[8];
#pragma unroll
    for (int nt = 0; nt < 8; ++nt) bbf[nt] = quad < 2 ? *(const bf16x8*)(bbcat + ((size_t)(g * 128 + nt * 16 + fr)) * 16 + quad * 8) : zero8;
    bf16x8 ccf[4];
    if (FULL) {
#pragma unroll
        for (int ks = 0; ks < 4; ++ks) ccf[ks] = *(const bf16x8*)(ccat + ((size_t)(g * 16 + fr)) * 128 + ks * 32 + quad * 8);
    }
    const float are = s5a[g * 64 + lane], aim = s5a[8192 + g * 64 + lane];
    float sre = 0.f, sim = 0.f;
    if (FULL) {
        if (samp) { const size_t o = ((size_t)(cidx - 128) * 128 + g) * 64 + lane; sre = A.in[4][o]; sim = A.in[5][o]; }
        else {
            const f32x2 e = *(const f32x2*)(E + ((size_t)(cidx * 128 + g) * 64 + lane) * 2); sre = e.x; sim = e.y;
        }
    }
    const float* gmix = A.in[6] + DM + g * 16;
    const f32x4 g0 = *(const f32x4*)(gmix + (quad & 1) * 8), g1 = *(const f32x4*)(gmix + (quad & 1) * 8 + 4);
    f32x4 gm = g0, dk = g0;
    if (FULL) { gm = *(const f32x4*)(gmix + quad * 4); dk = *(const f32x4*)(A.in[22] + g * 16 + quad * 4); }
#define S5_LOAD(sub_, a0, a1, av) do { const float* xr_ = X + (size_t)(rowbase + (sub_) * 16 + fr) * DM + g * 16; \
        if (quad < 2) { a0 = *(const f32x4*)(xr_ + quad * 8); a1 = *(const f32x4*)(xr_ + quad * 8 + 4); } if (FULL) av = *(const f32x4*)(xr_ + quad * 4); } while (0)
    const f32x4 z4 = (f32x4){0.f, 0.f, 0.f, 0.f};
    f32x4 n0 = z4, n1 = z4, nv = z4;
    S5_LOAD(0, n0, n1, nv);
    LDS_WAIT(); asm volatile("" ::: "memory");
#pragma unroll 1
    for (int sub = 0; sub < 4; ++sub) {
        const int row = rowbase + sub * 16 + fr; const float rr = rsl[sub * 16 + fr];
        const f32x4 c0 = n0, c1 = n1, cv = nv;
        if (sub < 3) S5_LOAD(sub + 1, n0, n1, nv);
        bf16x8 ua = zero8;
        if (quad < 2) ua = __builtin_bit_cast(bf16x8, pack8(c0 * g0 * rr, c1 * g1 * rr));
#pragma unroll
        for (int nt = 0; nt < 8; ++nt) { const f32x4 a = __builtin_amdgcn_mfma_f32_16x16x32_bf16(ua, bbf[nt], (f32x4){0.f, 0.f, 0.f, 0.f}, 0, 0, 0);
#pragma unroll
            for (int j = 0; j < 4; ++j) bu[(quad * 4 + j) * 132 + nt * 16 + fr] = a[j]; }
        LDS_WAIT(); asm volatile("" ::: "memory");
#pragma unroll
        for (int t = 0; t < 16; ++t) { const float re = bu[t * 132 + lane], im = bu[t * 132 + 64 + lane];
            const float nre = are * sre - aim * sim + re, nim = are * sim + aim * sre + im; sre = nre; sim = nim;
            if (FULL) { const unsigned w = cvt_pk_bf16(sre, sim); sb[t * 136 + lane] = (bf16_t)(w & 0xffffu); sb[t * 136 + 64 + lane] = (bf16_t)(w >> 16); } }
        if (FULL) {
            LDS_WAIT(); asm volatile("" ::: "memory");
            f32x4 y = (f32x4){0.f, 0.f, 0.f, 0.f};
#pragma unroll
            for (int ks = 0; ks < 4; ++ks) { const bf16x8 sf = *(const LAS bf16x8*)(sb + fr * 136 + ks * 32 + quad * 8); y = __builtin_amdgcn_mfma_f32_16x16x32_bf16(ccf[ks], sf, y, 0, 0, 0); }
            const f32x4 hh = cv * gm * rr;
            *(u32x2*)(yb + (size_t)row * DM + g * 16 + quad * 4) = pack4(gelu4(y + dk * hh));
        }
        LDS_WAIT(); asm volatile("" ::: "memory");
    }
#undef S5_LOAD
    if (FULL) {
        if (samp) { const size_t o = ((size_t)(cidx - 128) * 128 + g) * 64 + lane; A.out[O_SSR + o] = sre; A.out[O_SSI + o] = sim; }
        else if (cidx == 127) { A.out[O_SPR + g * 64 + lane] = sre; A.out[O_SPI + g * 64 + lane] = sim; }
    } else {
        *(f32x2*)(E + ((size_t)(cidx * 128 + g) * 64 + lane) * 2) = (f32x2){sre, sim};
    }
}

DI f32x4 pb_sum(const float* pb, int r, int col) {
    const int su = (r >> 8) * 8 + (col >> 8); const float* p = pb + (size_t)su * 8 * 65536 + (size_t)(r & 255) * 256 + (col & 255);
    f32x4 s = *(const f32x4*)p;
#pragma unroll
    for (int pc = 1; pc < 8; ++pc) s += *(const f32x4*)(p + (size_t)pc * 65536);
    return s;
}
constexpr int CV_IN = 32 * 104, CV_OUT = 32 * 64, CV_G = 32 * 176, CV_D = 88 * 64, CV_GL = 32 * 64;
constexpr int CV_A1 = CV_IN, CV_A2 = CV_A1 + CV_OUT, CV_A3 = CV_A2 + 2 * CV_G, CV_A4 = CV_A3 + 2 * CV_GL, CV_A5 = CV_A4 + CV_D, CV_A6 = CV_A5 + 2 * CV_G, CV_A7 = CV_A6 + CV_D;
DI void conv_items(const Args& A, unsigned char* ws, int first, int last, int worker, int nworkers, LAS float* scr, int lane, bool skip_early) {
    const float* nmix = A.in[6]; const float* nffn = A.in[7];
    bf16_t* Wt_in = (bf16_t*)(ws + WS_WIN); bf16_t* Wt_out = (bf16_t*)(ws + WS_WOUT); bf16_t* Wt_gu0 = (bf16_t*)(ws + WS_WGU0); bf16_t* Wt_d0 = (bf16_t*)(ws + WS_WD0);
    bf16_t* Wt_glu = (bf16_t*)(ws + WS_WGLU); bf16_t* Wt_gu1 = (bf16_t*)(ws + WS_WGU1); bf16_t* Wt_d1 = (bf16_t*)(ws + WS_WD1);
    for (int it = first + worker; it < last; it += nworkers) {
        int r = it;
        if (r < CV_IN) { tr_mat(A.in[9], DIN0, 0, DM, DIN0, nmix, Wt_in, 0, 0, scr, r, lane); continue; } r -= CV_IN;
        if (r < CV_OUT) { tr_mat(A.in[14], DM, 0, DM, DM, nullptr, Wt_out, 0, 0, scr, r, lane); continue; } r -= CV_OUT;
        if (r < CV_G) { if (!(skip_early && (r % 176) < 8)) tr_mat(A.in[24], DFF, 0, DM, DFF, nffn, Wt_gu0, 1, 0, scr, r, lane); continue; } r -= CV_G;
        if (r < CV_G) { if (!(skip_early && (r % 176) < 8)) tr_mat(A.in[25], DFF, 0, DM, DFF, nffn, Wt_gu0, 1, 1, scr, r, lane); continue; } r -= CV_G;
        if (r < CV_GL) { tr_mat(A.in[23], 2 * DM, 0, DM, DM, nullptr, Wt_glu, 1, 0, scr, r, lane); continue; } r -= CV_GL;
        if (r < CV_GL) { tr_mat(A.in[23], 2 * DM, DM, DM, DM, nullptr, Wt_glu, 1, 1, scr, r, lane); continue; } r -= CV_GL;
        if (r < CV_D) { tr_mat(A.in[26], DM, 0, DFF, DM, nullptr, Wt_d0, 0, 0, scr, r, lane); continue; } r -= CV_D;
        if (r < CV_G) { if (!(skip_early && (r % 176) < 8)) tr_mat(A.in[24] + (size_t)DM * DFF, DFF, 0, DM, DFF, nffn + DM, Wt_gu1, 1, 0, scr, r, lane); continue; } r -= CV_G;
        if (r < CV_G) { if (!(skip_early && (r % 176) < 8)) tr_mat(A.in[25] + (size_t)DM * DFF, DFF, 0, DM, DFF, nffn + DM, Wt_gu1, 1, 1, scr, r, lane); continue; } r -= CV_G;
        tr_mat(A.in[26] + (size_t)DFF * DM, DM, 0, DFF, DM, nullptr, Wt_d1, 0, 0, scr, r, lane);
    }
}
DI void conv_early(const Args& A, unsigned char* ws, int worker, int nworkers, LAS float* scr, int lane) {
    const float* nffn = A.in[7];
    for (int e = worker; e < 1024; e += nworkers) {
        const int lay = e >> 9, mat = (e >> 8) & 1, kb = (e & 255) >> 3, nb = e & 7;
        tr_mat(A.in[24 + mat] + (size_t)lay * DM * DFF, DFF, 0, DM, DFF, nffn + lay * DM, (bf16_t*)(ws + (lay ? WS_WGU1 : WS_WGU0)), 1, mat, scr, kb * 176 + nb, lane);
    }
}
#define XB_TMO      128
#define XB_XCNT(j)  (256  + 64 * (j))
#define XB_XSUB(j)  (1280 + 64 * (j))
#define XB_XGEN(j)  (2304 + 64 * (j))
#define XB_TOP      3328
#define XB_TOPGEN   3392
#define XCD_BAR_WORDS 3456
#define XB_SPIN_CAP (1u << 18)
DI unsigned xb_ld(unsigned* p)              { return __hip_atomic_load(p, __ATOMIC_RELAXED, __HIP_MEMORY_SCOPE_AGENT); }
DI unsigned xb_add(unsigned* p, unsigned v) { return __hip_atomic_fetch_add(p, v, __ATOMIC_RELAXED, __HIP_MEMORY_SCOPE_AGENT); }
DI unsigned xb_xcc_id() { return (unsigned)__builtin_amdgcn_s_getreg((3 << 11) | 20) & 0xFu; }
#define XB_SPIN(cond, bar) do { unsigned _sp = 0; while (cond) { __builtin_amdgcn_s_sleep(1); \
    if ((++_sp & 255u) == 0u) { if (xb_ld(&(bar)[XB_TMO])) break; if (_sp > XB_SPIN_CAP) { atomicAdd(&(bar)[XB_TMO], 1u); break; } } } } while (0)
struct XcdBarrier { unsigned* bar; unsigned x; volatile LAS unsigned* st; };
DI XcdBarrier xcd_barrier_post(unsigned* bar, volatile LAS unsigned* st) {
    XcdBarrier b; b.bar = bar; b.x = xb_xcc_id(); b.st = st;
    if (threadIdx.x == 0) (void)xb_add(&bar[XB_XCNT(b.x)], 1u);
    return b;
}
DI void xcd_barrier_complete(unsigned* bar, unsigned x, unsigned& nloc, unsigned& nx) {
    const unsigned G = gridDim.x * gridDim.y * gridDim.z;
    unsigned sum, cnt, mine, sp = 0u;
    for (;;) {
        sum = 0u; cnt = 0u; mine = 0u;
#pragma unroll
        for (unsigned j = 0; j < 16; ++j) { const unsigned c = xb_ld(&bar[XB_XCNT(j)]); sum += c; cnt += (c > 0u) ? 1u : 0u; mine = (j == x) ? c : mine; }
        if (sum == G) break;
        __builtin_amdgcn_s_sleep(1);
        if ((++sp & 255u) == 0u) { if (xb_ld(&bar[XB_TMO])) break; if (sp > XB_SPIN_CAP) { atomicAdd(&bar[XB_TMO], 1u); break; } }
    }
    nloc = mine > 0u ? mine : 1u; nx = cnt > 0u ? cnt : 1u;
}
DI void xcd_barrier(const XcdBarrier& b) {
    asm volatile("s_waitcnt vmcnt(0)" ::: "memory");
    __syncthreads();
    if (threadIdx.x == 0) {
        unsigned* bar = b.bar;
        __builtin_amdgcn_s_waitcnt(0);
        unsigned nloc = b.st[0], nx = b.st[1];
        if (nloc == 0u) { xcd_barrier_complete(bar, b.x, nloc, nx); b.st[0] = nloc; b.st[1] = nx; }
        const unsigned old = xb_add(&bar[XB_XSUB(b.x)], 1u);
        const unsigned gen = old / nloc;
        if (old + 1u == (gen + 1u) * nloc) {
            __builtin_amdgcn_fence(__ATOMIC_RELEASE, "agent");
            asm volatile("s_waitcnt vmcnt(0)" ::: "memory");
            const unsigned og = xb_add(&bar[XB_TOP], 1u);
            const unsigned tg = og / nx;
            if (og + 1u == (tg + 1u) * nx) xb_add(&bar[XB_TOPGEN], 1u);
            else XB_SPIN(xb_ld(&bar[XB_TOPGEN]) == tg, bar);
            __builtin_amdgcn_fence(__ATOMIC_ACQUIRE, "agent");
            xb_add(&bar[XB_XGEN(b.x)], 1u);
            asm volatile("s_waitcnt vmcnt(0)" ::: "memory");
        } else {
            XB_SPIN(xb_ld(&bar[XB_XGEN(b.x)]) == gen, bar);
            __builtin_amdgcn_fence(__ATOMIC_ACQUIRE, "agent");
            asm volatile("s_waitcnt vmcnt(0)" ::: "memory");
        }
    }
    __syncthreads();
}
#define GSYNC() do { asm volatile("s_waitcnt vmcnt(0)" ::: "memory"); grid.sync(); asm volatile("s_waitcnt vmcnt(0)" ::: "memory"); __syncthreads(); } while (0)
#define CONV_TAIL(nu, first, last) do { const int _r = (nu) % G; \
    if (_r != 0) { if (bx >= _r) conv_items(A, ws, (first), (last), (bx - _r) * 8 + wave, (G - _r) * 8, (LAS float*)(lds + wave * 16384), fresh_tid() & 63, false); } \
    else conv_items(A, ws, (first), (last), gw, NGW, (LAS float*)(lds + wave * 16384), fresh_tid() & 63, false); } while (0)
__global__ void __launch_bounds__(512, 2) mega_fwd(Args A) {
    extern __shared__ __attribute__((aligned(16))) unsigned char lds_raw[];
    LAS unsigned char* lds = (LAS unsigned char*)lds_raw;
    cg::grid_group grid = cg::this_grid();
    const int wave = __builtin_amdgcn_readfirstlane((int)threadIdx.x >> 6);
    const int G = gridDim.x, bx = blockIdx.x, gw = bx * 8 + wave, NGW = G * 8, NGT = G * 512;
    unsigned char* ws = A.ws;
    float* rstd0 = (float*)(ws + WS_RSTD0); float* gpart = (float*)(ws + WS_GPART); float* part = (float*)(ws + WS_PART);
    float* s5a = (float*)(ws + WS_S5A); bf16_t* bbcat = (bf16_t*)(ws + WS_BBCAT); bf16_t* ccat = (bf16_t*)(ws + WS_CCAT); bf16_t* wmb = (bf16_t*)(ws + WS_WMB);
    float* E = (float*)(ws + WS_E);
    bf16_t* Wt_in = (bf16_t*)(ws + WS_WIN); bf16_t* Wt_out = (bf16_t*)(ws + WS_WOUT); bf16_t* Wt_gu0 = (bf16_t*)(ws + WS_WGU0); bf16_t* Wt_d0 = (bf16_t*)(ws + WS_WD0);
    bf16_t* Wt_glu = (bf16_t*)(ws + WS_WGLU); bf16_t* Wt_gu1 = (bf16_t*)(ws + WS_WGU1); bf16_t* Wt_d1 = (bf16_t*)(ws + WS_WD1);
    bf16_t* XB = (bf16_t*)(ws + WS_XB); bf16_t* ACT = (bf16_t*)(ws + WS_R);
    bf16_t* qb = (bf16_t*)(ws + WS_QB); bf16_t* ub = (bf16_t*)(ws + WS_UB); bf16_t* gvb = (bf16_t*)(ws + WS_GVB); bf16_t* kb = (bf16_t*)(ws + WS_KB); bf16_t* vb = (bf16_t*)(ws + WS_VB);
    bf16_t* omix = (bf16_t*)(ws + WS_OMIX); bf16_t* yb = (bf16_t*)(ws + WS_YB);
    if (threadIdx.x < 2) ((volatile LAS unsigned*)(lds + 131072))[threadIdx.x] = 0u;
    __syncthreads();
    const XcdBarrier xbar = xcd_barrier_post((unsigned*)(ws + WS_BAR), (volatile LAS unsigned*)(lds + 131072));
const bool fastbar = (gridDim.x == 256);
#define XSYNC() do { if (fastbar) xcd_barrier(xbar); else GSYNC(); } while (0)
    float* PB = (float*)(ws + WS_PB);
    float* X = A.out;

    for (int rep = 0; rep <= DUP_P0; ++rep) {
        const int tid = fresh_tid(), lane = tid & 63, gt = bx * 512 + tid;
        LAS float* scr = (LAS float*)(lds + wave * 16384);
        conv_items(A, ws, 0, CV_A1, gw, NGW, scr, lane, false);
        for (int row = gw; row < MTOK; row += NGW) {
            const float* xr = row < MP ? A.in[0] + (size_t)row * DM : A.in[1] + (size_t)(row - MP) * DM;
            f32x4 v[8]; float s = 0.f;
#pragma unroll
            for (int j = 0; j < 8; ++j) { v[j] = *(const f32x4*)(xr + (lane + 64 * j) * 4); s += sumsq4(v[j]); }
            s = wave_sum(s);
            if (lane == 0) rstd0[row] = rsqrtf(s * (1.0f / 2048.0f) + RMS_EPS);
#pragma unroll
            for (int j = 0; j < 8; ++j) *(u32x2*)(XB + (size_t)row * DM + (lane + 64 * j) * 4) = pack4(v[j]);
        }
        for (int idx = gt; idx < 8192; idx += NGT) {
            const int g = idx >> 6;
            const float dt = expf(A.in[17][g]), lr = A.in[15][idx], li = A.in[16][idx];
            const float mag = expf(lr * dt); float sn, cs; sincos_f(li * dt, sn, cs);
            const float are = mag * cs, aim = mag * sn, den = lr * lr + li * li, nr = are - 1.0f;
            const float fre = (nr * lr + aim * li) / den, fim = (aim * lr - nr * li) / den;
            const int p = idx & 63;
#pragma unroll
            for (int i = 0; i < 16; ++i) { const float br = A.in[18][(size_t)idx * 16 + i], bi = A.in[19][(size_t)idx * 16 + i];
                bbcat[((size_t)(g * 128 + p)) * 16 + i] = (bf16_t)f2bf(fre * br - fim * bi); bbcat[((size_t)(g * 128 + 64 + p)) * 16 + i] = (bf16_t)f2bf(fre * bi + fim * br); }
            float pr = are, pi = aim;
#pragma unroll
            for (int k = 0; k < 6; ++k) { const float t0 = pr * pr - pi * pi, t1 = 2.0f * pr * pi; pr = t0; pi = t1; }
            s5a[idx] = are; s5a[8192 + idx] = aim; s5a[16384 + idx] = pr; s5a[24576 + idx] = pi;
        }
        for (int idx = gt; idx < 128 * 16 * 64; idx += NGT) {
            const int p = idx & 63, gi = idx >> 6;
            ccat[(size_t)gi * 128 + p] = (bf16_t)f2bf(A.in[20][idx]); ccat[(size_t)gi * 128 + 64 + p] = (bf16_t)f2bf(-A.in[21][idx]);
        }
        for (int idx = gt; idx < 16 * 128 * 128; idx += NGT) {
            const int s = idx & 127, t = (idx >> 7) & 127;
            wmb[idx] = ((t >> 6) >= (s >> 6)) ? (bf16_t)f2bf(A.in[12][idx]) : (bf16_t)0;
        }
    }
    XSYNC();
    {
        pg8::Gemm g{XB, Wt_in, MTOK, DIN0, DM}; pg8::StaticOrder S; S.init(MTOK, DIN0, G, bx);
        EpiIn Ep{rstd0, qb, kb, vb, ub, gvb, gpart, A.out};
        pg8::gemm_phase<EpiIn, pg8::StaticOrder, true, true>(lds, g, S, Ep);
        CONV_TAIL((MTOK / 256) * (DIN0 / 256), CV_A1, CV_A2);
        if (G == 256 && bx >= 212) conv_early(A, ws, (bx - 212) * 8 + wave, 44 * 8, (LAS float*)(lds + wave * 16384), fresh_tid() & 63);
    }
    XSYNC();
    if (G == 256) {
        const int tid = fresh_tid(), lane = tid & 63;
        attn_unit(lds, bx, A, qb, kb, vb, omix, tid, wave, lane);
        if (bx < 32) { attn_unit(lds, 256 + bx, A, qb, kb, vb, omix, tid, wave, lane);
            gm_unit(lds, 1120 + 2 * bx, A, ub, gvb, gpart, wmb, omix, tid, wave, lane); gm_unit(lds, 1121 + 2 * bx, A, ub, gvb, gpart, wmb, omix, tid, wave, lane); }
        else {
#pragma unroll 1
            for (int k = 0; k < 5; ++k) gm_unit(lds, (bx - 32) + 224 * k, A, ub, gvb, gpart, wmb, omix, tid, wave, lane);
            if (bx < 128) gm_unit(lds, 1184 + (bx - 32), A, ub, gvb, gpart, wmb, omix, tid, wave, lane);
        }
    } else
    for (int u = bx; u < 288 + 1280; u += G) {
        const int tid = fresh_tid(), lane = tid & 63;
        if (u < 288) attn_unit(lds, u, A, qb, kb, vb, omix, tid, wave, lane);
        else gm_unit(lds, u - 288, A, ub, gvb, gpart, wmb, omix, tid, wave, lane);
    }
    XSYNC();
    if (G == 256) {
        pg8::Gemm g{omix, Wt_out, MTOK, DM, DM}; EpiRes Ep{A.in[0], A.in[1], X, XB, part, nullptr, 0};
        { pg8::StaticOrder S; S.init(MP, DM, G, bx); pg8::gemm_phase<EpiRes, pg8::StaticOrder, true, true>(lds, g, S, Ep); }
        XSYNC();
        if (bx < 32) { pg8::OneUnit S{32 + (bx >> 3), bx & 7}; pg8::gemm_phase<EpiRes, pg8::OneUnit, true, true>(lds, g, S, Ep); }
        else if (bx < 80) { const int e = bx - 32; pg8::OneUnit S{pg8::early_panel(0, e >> 1), e & 1}; pg8::Gemm g4{XB, Wt_gu0, MTOK, 2 * DFF, DM}; EpiSwiglu<32> E4{part, ACT};
            pg8::gemm_phase<EpiSwiglu<32>, pg8::OneUnit, true, true>(lds, g4, S, E4); }
        else conv_items(A, ws, CV_A2, CV_A4, (bx - 80) * 8 + wave, 176 * 8, (LAS float*)(lds + wave * 16384), fresh_tid() & 63, true);
    } else {
        pg8::Gemm g{omix, Wt_out, MTOK, DM, DM}; pg8::StaticOrder S; S.init(MTOK, DM, G, bx);
        EpiRes Ep{A.in[0], A.in[1], X, XB, part, nullptr, 0};
        pg8::gemm_phase<EpiRes, pg8::StaticOrder, true, true>(lds, g, S, Ep);
        CONV_TAIL((MTOK / 256) * (DM / 256), CV_A2, CV_A3);
    }
    XSYNC();
    {
        pg8::Gemm g{XB, Wt_gu0, MTOK, 2 * DFF, DM}; EpiSwiglu<32> Ep{part, ACT};
        if (G == 256) { pg8::SkipOrder S; S.init(G, bx, 0); pg8::gemm_phase<EpiSwiglu<32>, pg8::SkipOrder, true, true>(lds, g, S, Ep);
            conv_items(A, ws, CV_A4, CV_A5, gw, NGW, (LAS float*)(lds + wave * 16384), fresh_tid() & 63, false); }
        else { pg8::StaticOrder S; S.init(MTOK, 2 * DFF, G, bx); pg8::gemm_phase<EpiSwiglu<32>, pg8::StaticOrder, true, true>(lds, g, S, Ep);
            CONV_TAIL((MTOK / 256) * (2 * DFF / 256), CV_A3, CV_A5); }
    }
    XSYNC();
    {
        pg8::Gemm g{ACT, Wt_d0, MTOK, DM, DFF};
        if (G == 256) { pg8::SplitOrder S; S.init(DFF, bx); EpiRes Ep{X, X + (size_t)MP * DM, X, nullptr, part, PB, DFF / 64};
            pg8::gemm_phase<EpiRes, pg8::SplitOrder, true, true>(lds, g, S, Ep); }
        else { pg8::StaticOrder S; S.init(MTOK, DM, G, bx); EpiRes Ep{X, X + (size_t)MP * DM, X, nullptr, part, nullptr, 0};
            pg8::gemm_phase<EpiRes, pg8::StaticOrder, true, true>(lds, g, S, Ep); }
    }
    XSYNC();
    for (int rep = 0; rep <= DUP_P6; ++rep) {
        const int lane = fresh_tid() & 63;
        if (G == 256 && rep == 0) {
            const int r = gw >> 1, half = gw & 1;
            float* xr = X + (size_t)(MP + r) * DM + half * 1024; float sq = 0.f;
#pragma unroll
            for (int j = 0; j < 4; ++j) { const int col = (lane + 64 * j) * 4; const f32x4 v = *(const f32x4*)(xr + col) + pb_sum(PB, r, half * 1024 + col); *(f32x4*)(xr + col) = v; sq += sumsq4(v); }
            sq = wave_sum(sq);
            if (lane < 16) part[(size_t)(MP + r) * 32 + 2 * lane + half] = lane == 0 ? sq : 0.f;
        }
        LAS unsigned char* wl = lds + wave * 16384;
        { const int per = (128 * 128 + NGW - 1) / NGW; int prev = -1;
          for (int k = 0; k < per; ++k) { const int it = gw * per + k; if (it >= 128 * 128) break; const int c = it >> 7;
            s5_item<false>(wl, c, it & 127, c != prev, lane, A, X, part, s5a, bbcat, ccat, E, yb); prev = c; } }
    }
    XSYNC();
    {
        const int tid = fresh_tid();
        const int ch = bx * 32 + tid;
        if (tid < 32 && ch < 8192) {
            const float pre = s5a[16384 + ch], pim = s5a[24576 + ch];
            float sre = 0.f, sim = 0.f; float* Ep = E + (size_t)ch * 2;
#pragma unroll 1
            for (int c0 = 0; c0 < 128; c0 += 32) {
                f32x2 e[32];
#pragma unroll
                for (int k = 0; k < 32; ++k) e[k] = *(const f32x2*)(Ep + (size_t)(c0 + k) * 16384);
#pragma unroll
                for (int k = 0; k < 32; ++k) { *(f32x2*)(Ep + (size_t)(c0 + k) * 16384) = (f32x2){sre, sim};
                    const float nre = pre * sre - pim * sim + e[k].x, nim = pre * sim + pim * sre + e[k].y; sre = nre; sim = nim; }
            }
        }
    }
    XSYNC();
    for (int rep = 0; rep <= DUP_P6; ++rep) {
        const int lane = fresh_tid() & 63;
        LAS unsigned char* wl = lds + wave * 16384;
        { const int per = (144 * 128 + NGW - 1) / NGW; int prev = -1;
          for (int k = 0; k < per; ++k) { const int it = gw * per + k; if (it >= 144 * 128) break; const int c = it >> 7;
            s5_item<true>(wl, c, it & 127, c != prev, lane, A, X, part, s5a, bbcat, ccat, E, yb); prev = c; } }
    }
    XSYNC();
    {
        pg8::Gemm g{yb, Wt_glu, MTOK, 2 * DM, DM}; EpiGlu Ep{X, XB, part};
        if (G == 256) {
            { pg8::StaticOrder S; S.init(MP, 2 * DM, G, bx); pg8::gemm_phase<EpiGlu, pg8::StaticOrder, true, true>(lds, g, S, Ep); }
            XSYNC();
            if (bx < 64) { pg8::OneUnit S{32 + (bx >> 4), bx & 15}; pg8::gemm_phase<EpiGlu, pg8::OneUnit, true, true>(lds, g, S, Ep); }
            else if (bx < 112) { const int e = bx - 64; pg8::OneUnit S{pg8::early_panel(1, e >> 1), e & 1}; pg8::Gemm g8{XB, Wt_gu1, MTOK, 2 * DFF, DM}; EpiSwiglu<64> E8{part, ACT};
                pg8::gemm_phase<EpiSwiglu<64>, pg8::OneUnit, true, true>(lds, g8, S, E8); }
            else conv_items(A, ws, CV_A5, CV_A6, (bx - 112) * 8 + wave, 144 * 8, (LAS float*)(lds + wave * 16384), fresh_tid() & 63, true);
        } else {
            pg8::StaticOrder S; S.init(MTOK, 2 * DM, G, bx); pg8::gemm_phase<EpiGlu, pg8::StaticOrder, true, true>(lds, g, S, Ep);
            CONV_TAIL((MTOK / 256) * (2 * DM / 256), CV_A5, CV_A6);
        }
    }
    XSYNC();
    {
        pg8::Gemm g{XB, Wt_gu1, MTOK, 2 * DFF, DM}; EpiSwiglu<64> Ep{part, ACT};
        if (G == 256) { pg8::SkipOrder S; S.init(G, bx, 1); pg8::gemm_phase<EpiSwiglu<64>, pg8::SkipOrder, true, true>(lds, g, S, Ep);
            conv_items(A, ws, CV_A6, CV_A7, gw, NGW, (LAS float*)(lds + wave * 16384), fresh_tid() & 63, false); }
        else { pg8::StaticOrder S; S.init(MTOK, 2 * DFF, G, bx); pg8::gemm_phase<EpiSwiglu<64>, pg8::StaticOrder, true, true>(lds, g, S, Ep);
            CONV_TAIL((MTOK / 256) * (2 * DFF / 256), CV_A6, CV_A7); }
    }
    XSYNC();
    {
        pg8::Gemm g{ACT, Wt_d1, MTOK, DM, DFF};
        if (G == 256) { pg8::SplitOrder S; S.init(DFF, bx); EpiRes Ep{X, X + (size_t)MP * DM, X, nullptr, part, PB, DFF / 64};
            pg8::gemm_phase<EpiRes, pg8::SplitOrder, true, true>(lds, g, S, Ep); }
        else { pg8::StaticOrder S; S.init(MTOK, DM, G, bx); EpiRes Ep{X, X + (size_t)MP * DM, X, nullptr, part, nullptr, 0};
            pg8::gemm_phase<EpiRes, pg8::StaticOrder, true, true>(lds, g, S, Ep); }
    }
    XSYNC();
    {
        const int lane = fresh_tid() & 63;
        const bool deal = (G == 256);
        const int nrows = deal ? (gw < 1024 ? 1 : 8) : (MTOK - gw + NGW - 1) / NGW;
        for (int k = 0; k < nrows; ++k) {
            const int row = deal ? (gw < 1024 ? MP + gw : (gw - 1024) * 8 + k) : gw + k * NGW;
            float* xr = X + (size_t)row * DM; const float* gf = A.in[8];
            f32x4 v[8]; float s = 0.f;
#pragma unroll
            for (int j = 0; j < 8; ++j) { v[j] = *(const f32x4*)(xr + (lane + 64 * j) * 4); if (G == 256 && row >= MP) v[j] += pb_sum(PB, row - MP, (lane + 64 * j) * 4); s += sumsq4(v[j]); }
            s = wave_sum(s);
            const float rs = rsqrtf(s * (1.0f / 2048.0f) + RMS_EPS);
#pragma unroll
            for (int j = 0; j < 8; ++j) *(f32x4*)(xr + (lane + 64 * j) * 4) = v[j] * rs * *(const f32x4*)(gf + (lane + 64 * j) * 4);
        }
    }
}

extern "C" void kernel_launch(void* const* d_in, const int* in_sizes, int n_in, void* d_out, int out_size, void* d_ws, size_t ws_size, hipStream_t stream) {
    static int grid = 0;
    if (grid == 0) {
        if (n_in != 27 || ws_size < WS_END) { fprintf(stderr, "kernel_launch: need 27 inputs and >= %zu bytes of workspace (got %d, %zu)\n", (size_t)WS_END, n_in, ws_size); grid = -1; return; }
        int dev = 0, cus = 0, per_cu = 0;
        (void)hipGetDevice(&dev); (void)hipDeviceGetAttribute(&cus, hipDeviceAttributeMultiprocessorCount, dev);
        if (hipFuncSetAttribute((const void*)mega_fwd, hipFuncAttributeMaxDynamicSharedMemorySize, LDS_BYTES) != hipSuccess) { fprintf(stderr, "kernel_launch: hipFuncSetAttribute failed\n"); grid = -1; return; }
        if (hipOccupancyMaxActiveBlocksPerMultiprocessor(&per_cu, (const void*)mega_fwd, 512, LDS_BYTES) != hipSuccess || per_cu < 1) { fprintf(stderr, "kernel_launch: occupancy query failed (%d)\n", per_cu); (void)hipGetLastError(); per_cu = 1; }
        grid = cus * 1;
        if (grid > cus * per_cu) grid = cus * per_cu;
    }
    if (grid < 0) return;
    if (hipMemsetAsync((char*)d_ws + WS_BAR, 0, 16384, stream) != hipSuccess) { fprintf(stderr, "kernel_launch: memset of the barrier words failed\n"); return; }
    Args a{};
    for (int i = 0; i < 27; ++i) a.in[i] = (const float*)d_in[i];
    a.out = (float*)d_out; a.ws = (unsigned char*)d_ws;
    void* args[] = {&a};
    hipError_t e = hipLaunchCooperativeKernel((const void*)mega_fwd, dim3(grid), dim3(512), args, LDS_BYTES, stream);
    if (e != hipSuccess) fprintf(stderr, "cooperative launch failed: %s (grid %d)\n", hipGetErrorString(e), grid);
}
```

```cpp
#include <hip/hip_runtime.h>
#include <hip/hip_cooperative_groups.h>
#include <cstdio>
#include <cstdint>
namespace cg = cooperative_groups;
#ifndef DUP_P0
#define DUP_P0 0
#endif
#ifndef DUP_P2
#define DUP_P2 0
#endif
#ifndef DUP_P6
#define DUP_P6 0
#endif

#define LAS __attribute__((address_space(3)))
#define DI __device__ __forceinline__
typedef unsigned short bf16_t;
typedef short bf16x8 __attribute__((ext_vector_type(8)));
typedef float f32x4 __attribute__((ext_vector_type(4)));
typedef float f32x2 __attribute__((ext_vector_type(2)));
typedef unsigned u32x4 __attribute__((ext_vector_type(4)));
typedef unsigned u32x2 __attribute__((ext_vector_type(2)));

constexpr int MTOK = 9216, MP = 8192, DM = 2048, DIN0 = 3328, DFF = 5632;
constexpr float RMS_EPS = 1e-5f;
constexpr size_t MiB = 1u << 20;
constexpr size_t WS_RSTD0 = 0;
constexpr size_t WS_BAR   = 40 * 1024;
constexpr size_t WS_GPART = 64 * 1024;
constexpr size_t WS_PART  = 1 * MiB;
constexpr size_t WS_S5A   = 4 * MiB;
constexpr size_t WS_BBCAT = WS_S5A + 128 * 1024;
constexpr size_t WS_CCAT  = WS_BBCAT + 512 * 1024;
constexpr size_t WS_WMB   = WS_CCAT + 512 * 1024;
constexpr size_t WS_E     = 6 * MiB;
constexpr size_t WS_WIN   = 16 * MiB;
constexpr size_t WS_WOUT  = 29 * MiB;
constexpr size_t WS_WGU0  = 37 * MiB;
constexpr size_t WS_WD0   = 81 * MiB;
constexpr size_t WS_WGLU  = 103 * MiB;
constexpr size_t WS_WGU1  = 119 * MiB;
constexpr size_t WS_WD1   = 163 * MiB;
constexpr size_t WS_XB    = 185 * MiB;
constexpr size_t WS_R     = 221 * MiB;
constexpr size_t WS_QB    = WS_R;
constexpr size_t WS_UB    = WS_R + 18 * MiB;
constexpr size_t WS_GVB   = WS_R + 36 * MiB;
constexpr size_t WS_KB    = WS_R + 54 * MiB;
constexpr size_t WS_VB    = WS_R + 57 * MiB;
constexpr size_t WS_OMIX  = WS_R + 60 * MiB;
constexpr size_t WS_YB    = WS_R;
constexpr size_t WS_PB    = 320 * MiB;
constexpr size_t WS_END   = 384 * MiB;
constexpr size_t O_KP = 18874368, O_VP = 18890752, O_KS = 18907136, O_VS = 19038208, O_GV = 19169280,
                 O_SPR = 20217856, O_SPI = 20226048, O_SSR = 20234240, O_SSI = 20365312;

constexpr int LDS_BYTES = 132096;

#define LDS_WAIT() asm volatile("s_waitcnt lgkmcnt(0)" ::: "memory")
DI unsigned f2bf(float f) { unsigned u = __builtin_bit_cast(unsigned, f); return (u + 0x7fffu + ((u >> 16) & 1u)) >> 16; }
DI float bf2f(unsigned h) { return __builtin_bit_cast(float, h << 16); }
typedef __bf16 bf16x2_t __attribute__((ext_vector_type(2)));
DI unsigned cvt_pk_bf16(float lo, float hi) { const f32x2 v = {lo, hi}; const bf16x2_t b = __builtin_convertvector(v, bf16x2_t); return __builtin_bit_cast(unsigned, b); }
DI u32x4 pack8(f32x4 a, f32x4 b) { u32x4 w; w.x = cvt_pk_bf16(a[0], a[1]); w.y = cvt_pk_bf16(a[2], a[3]); w.z = cvt_pk_bf16(b[0], b[1]); w.w = cvt_pk_bf16(b[2], b[3]); return w; }
DI u32x2 pack4(f32x4 a) { u32x2 w; w.x = cvt_pk_bf16(a[0], a[1]); w.y = cvt_pk_bf16(a[2], a[3]); return w; }
DI f32x2 gelu_pk(f32x2 v) {
    const f32x2 av = __builtin_elementwise_abs(v), d = av * 0.2316418882f + 1.0f;
    f32x2 t; t.x = __builtin_amdgcn_rcpf(d.x); t.y = __builtin_amdgcn_rcpf(d.y);
    f32x2 q = t * 0.5307027145f + (-0.7265760135f); q = q * t + 0.7107068705f; q = q * t + (-0.142248368f); q = q * t + 0.127414796f; q = q * t;
    const f32x2 s = (v * v) * (-0.72134752044f);
    f32x2 e; e.x = __builtin_amdgcn_exp2f(s.x); e.y = __builtin_amdgcn_exp2f(s.y);
    const f32x2 m = v * (q * e), r = v - m;
    f32x2 o; o.x = v.x < 0.f ? m.x : r.x; o.y = v.y < 0.f ? m.y : r.y; return o;
}
DI f32x4 gelu4(f32x4 v) { f32x2 a = gelu_pk((f32x2){v[0], v[1]}), b = gelu_pk((f32x2){v[2], v[3]}); return (f32x4){a.x, a.y, b.x, b.y}; }
DI float sigmoidf_(float x) { return __builtin_amdgcn_rcpf(1.0f + __expf(-x)); }
DI float sumsq4(f32x4 v) { return (v[0] * v[0] + v[1] * v[1]) + (v[2] * v[2] + v[3] * v[3]); }

namespace pg8 {
constexpr int BM = 256, BK = 64, HALF = 128, HTB = HALF * BK * 2, STAGE_BYTES = 8 * HTB, NXCD = 8, WGM = 8;
__host__ __device__ __forceinline__ int lds_byte(int r, int c) { const int st = (r >> 4) * 2 + (c >> 5), rr = r & 15, cc = c & 31, ob = rr * 64 + cc * 2; return st * 1024 + (ob ^ (((ob >> 9) & 1) << 5)); }
__host__ __device__ __forceinline__ void stage_rc(int b, int& R, int& C) { const int st = b / 1024, sb = b % 1024, swz = sb ^ (((sb >> 9) & 1) << 5); R = (st >> 1) * 16 + swz / 64; C = (st & 1) * 32 + (swz % 64) / 2; }
__host__ __device__ __forceinline__ int perm32(int rho) { const int n = rho >> 4, i = rho & 15; return 8 * (i >> 2) + 4 * n + (i & 3); }
struct Unit { int pm, pn, k0, nkt, aux; };
struct Gemm { const bf16_t* A; const bf16_t* Bt; int M, N, K; };
struct StaticOrder {
    static constexpr bool VARK = false;
    int nM, nN, nwg, G, c;
    __host__ __device__ void init(int M, int N, int G_, int c_) { nM = M / BM; nN = N / BM; nwg = nM * nN; G = G_; c = c_; }
    __host__ __device__ bool next(int i, Unit& u) const {
        const long L = (long)i * G + c; if (L >= nwg) return false;
        int wgid = (int)L; { const int q = nwg / NXCD, r = nwg % NXCD, xcd = wgid % NXCD, off = wgid / NXCD; wgid = (xcd < r ? xcd * (q + 1) : r * (q + 1) + (xcd - r) * q) + off; }
        const int nig = WGM * nN, gid = wgid / nig, fm = gid * WGM, gsz = (nM - fm) < WGM ? (nM - fm) : WGM;
        u.pm = fm + ((wgid % nig) % gsz); u.pn = (wgid % nig) / gsz; u.k0 = 0; u.nkt = 0; u.aux = 0; return true;
    }
    __device__ __forceinline__ void a_ready(const Unit&) const {}
    __device__ __forceinline__ void done(const Unit&) const {}
};
struct SplitOrder {
    static constexpr bool VARK = true;
    StaticOrder so; int c, nkt_full;
    __host__ __device__ void init(int K, int c_) { so.init(8192, 2048, 256, c_); c = c_; nkt_full = K / BK; }
    __host__ __device__ bool next(int i, Unit& u) const {
        if (i == 0) { so.next(0, u); u.k0 = 0; u.nkt = nkt_full; u.aux = 0; return true; }
        if (i == 1) { const int su = c >> 3, pc = c & 7; u.pm = 32 + (su >> 3); u.pn = su & 7; u.aux = c;
            const int npair = nkt_full / 2, base = npair / 8, rem = npair % 8;
            const int p0 = pc < rem ? pc * (base + 1) : rem * (base + 1) + (pc - rem) * base, np = pc < rem ? base + 1 : base;
            u.k0 = 2 * p0; u.nkt = 2 * np; return true; }
        return false;
    }
    __device__ __forceinline__ void a_ready(const Unit&) const {}
    __device__ __forceinline__ void done(const Unit&) const {}
};
struct OneUnit {
    static constexpr bool VARK = false;
    int pm, pn;
    __device__ __forceinline__ bool next(int i, Unit& u) const { if (i != 0) return false; u.pm = pm; u.pn = pn; u.k0 = 0; u.nkt = 0; u.aux = 0; return true; }
    __device__ __forceinline__ void a_ready(const Unit&) const {}
    __device__ __forceinline__ void done(const Unit&) const {}
};
__host__ __device__ __forceinline__ int early_panel(int lay, int e) { return (lay == 0 || e < 11) ? e : e + 3; }
__host__ __device__ __forceinline__ int late_panel(int lay, int q) { return (lay == 0 || q >= 3) ? 24 + q : 11 + q; }
struct SkipOrder {
    static constexpr bool VARK = false;
    StaticOrder so; int G, c, lay;
    __host__ __device__ void init(int G_, int c_, int lay_) { so.init(36 * 256, 42 * 256, G_, c_); G = G_; c = c_; lay = lay_; }
    __host__ __device__ bool next(int i, Unit& u) const {
        if (so.next(i, u)) { u.pn += 2; return true; }
        const long L = (long)i * G + c - so.nwg; if (L < 0 || L >= 24) return false;
        u.pm = late_panel(lay, (int)(L >> 1)); u.pn = (int)(L & 1); u.k0 = 0; u.nkt = 0; u.aux = 0; return true;
    }
    __device__ __forceinline__ void a_ready(const Unit&) const {}
    __device__ __forceinline__ void done(const Unit&) const {}
};
template <class Epi, class Sched, bool ALIGN_EPI = false, bool SP2 = false>
__device__ __forceinline__ void gemm_phase(LAS unsigned char* lds, const Gemm g, const Sched& S, const Epi& E) {
    const int tid = threadIdx.x, wid = __builtin_amdgcn_readfirstlane(tid >> 6), lane = tid & 63, wr = wid >> 2, wc = wid & 3, fr = lane & 15, fq = lane >> 4;
    const int K = g.K, nt = K / BK;
    unsigned voffA[2], voffB[2];
#pragma unroll
    for (int i = 0; i < 2; ++i) { int R, C; stage_rc(tid * 16 + i * 8192, R, C); const int Rb = Epi::PERM ? ((R & ~31) + perm32(R & 31)) : R;
        voffA[i] = (unsigned)(R * K + C) * 2u; voffB[i] = (unsigned)(Rb * K + C) * 2u; }
    const size_t kstep = (size_t)(BK * 2);
    const size_t hstep = (size_t)HALF * K * 2;
    const size_t tstep = 2 * hstep;
    const unsigned ldsw = (unsigned)wid * 1024u;
    const int aoff = lds_byte(wr * 64 + fr, fq * 8), boff = lds_byte(wc * 32 + fr, fq * 8);
#define PG8_SA(b, h) (((b) * 2 + (h)) * HTB)
#define PG8_SB(b, h) ((4 + (b) * 2 + (h)) * HTB)
#define PG8_STAGE(bufoff, gbase, voff) do { _Pragma("unroll") for (int _i = 0; _i < 2; ++_i) \
        __builtin_amdgcn_global_load_lds((const unsigned*)((const char*)(gbase) + (voff)[_i]), (LAS unsigned*)(lds + (bufoff) + ldsw + _i * 8192), 16, 0, 0); } while (0)
#define PG8_LDA(dst, b, h) do { _Pragma("unroll") for (int m = 0; m < 4; ++m) _Pragma("unroll") for (int k = 0; k < 2; ++k) dst[m][k] = *(const LAS bf16x8*)(lds + PG8_SA(b, h) + aoff + m * 2048 + k * 1024); } while (0)
#define PG8_LDB(dst, b, h) do { _Pragma("unroll") for (int n = 0; n < 2; ++n) _Pragma("unroll") for (int k = 0; k < 2; ++k) dst[n][k] = *(const LAS bf16x8*)(lds + PG8_SB(b, h) + boff + n * 2048 + k * 1024); } while (0)
#define PG8_MMA(ai, bj, At, Bt) do { __builtin_amdgcn_s_setprio(1); _Pragma("unroll") for (int m = 0; m < 4; ++m) _Pragma("unroll") for (int n = 0; n < 2; ++n) _Pragma("unroll") for (int k = 0; k < 2; ++k) \
        acc[ai][bj][m][n] = __builtin_amdgcn_mfma_f32_16x16x32_bf16(Bt[n][k], At[m][k], acc[ai][bj][m][n], 0, 0, 0); __builtin_amdgcn_s_setprio(0); } while (0)
#define PG8_WAIT_V(n) asm volatile("s_waitcnt vmcnt(" #n ")" ::: "memory")
#define PG8_WAIT_L(n) asm volatile("s_waitcnt lgkmcnt(" #n ")" ::: "memory")
#define PG8_BAR __builtin_amdgcn_s_barrier()
#define PG8_SCHED __builtin_amdgcn_sched_barrier(0)
    Unit cur, nxt; int ui = 0;
    if (!S.next(0, cur)) return;
    f32x4 acc[2][2][4][2];
#pragma unroll
    for (int a = 0; a < 2; ++a)
#pragma unroll
        for (int b = 0; b < 2; ++b)
#pragma unroll
            for (int m = 0; m < 4; ++m)
#pragma unroll
                for (int n = 0; n < 2; ++n) acc[a][b][m][n] = (f32x4){0.f, 0.f, 0.f, 0.f};
    bf16x8 At[4][2], B0[2][2], B1[2][2];
    const char* cA = (const char*)g.A + (size_t)cur.pm * tstep; const char* cB = (const char*)g.Bt + (size_t)cur.pn * tstep;
    if constexpr (Sched::VARK) { cA += (size_t)cur.k0 * kstep; cB += (size_t)cur.k0 * kstep; }
    S.a_ready(cur);
    if constexpr (SP2) {
        PG8_STAGE(PG8_SB(0, 0), cB, voffB); PG8_STAGE(PG8_SB(0, 1), cB + hstep, voffB); PG8_STAGE(PG8_SA(0, 0), cA, voffA); PG8_STAGE(PG8_SA(0, 1), cA + hstep, voffA);
        if (wr == 1) PG8_BAR;
        PG8_WAIT_V(2); PG8_BAR;
        PG8_STAGE(PG8_SB(1, 0), cB + kstep, voffB); PG8_STAGE(PG8_SA(1, 0), cA + kstep, voffA); PG8_STAGE(PG8_SB(1, 1), cB + hstep + kstep, voffB);
        PG8_WAIT_V(6); PG8_BAR;
    } else {
        PG8_STAGE(PG8_SB(0, 0), cB, voffB); PG8_STAGE(PG8_SA(0, 0), cA, voffA); PG8_STAGE(PG8_SB(0, 1), cB + hstep, voffB); PG8_STAGE(PG8_SA(0, 1), cA + hstep, voffA);
        if (wr == 1) PG8_BAR;
        PG8_WAIT_V(4); PG8_BAR;
        PG8_STAGE(PG8_SB(1, 0), cB + kstep, voffB); PG8_STAGE(PG8_SA(1, 0), cA + kstep, voffA); PG8_STAGE(PG8_SB(1, 1), cB + hstep + kstep, voffB);
        PG8_WAIT_V(6); PG8_BAR;
    }
    for (;;) {
        const bool has_next = S.next(ui + 1, nxt);
        const char* nA = has_next ? (const char*)g.A + (size_t)nxt.pm * tstep : cA; const char* nB = has_next ? (const char*)g.Bt + (size_t)nxt.pn * tstep : cB;
        if constexpr (Sched::VARK) { if (has_next) { nA += (size_t)nxt.k0 * kstep; nB += (size_t)nxt.k0 * kstep; } }
        const int cnt = Sched::VARK ? cur.nkt : nt;
        for (int t = 0; t < cnt; t += 2) {
            const bool last = (t == cnt - 2);
            const char* a1 = cA + (size_t)(t + 1) * kstep;
            const char* a2 = last ? nA : cA + (size_t)(t + 2) * kstep; const char* b2 = last ? nB : cB + (size_t)(t + 2) * kstep;
            const char* a3 = a2 + kstep; const char* b3 = b2 + kstep;
            if (last && has_next) S.a_ready(nxt);
            if constexpr (SP2) {
            PG8_LDB(B0, 0, 0); PG8_LDB(B1, 0, 1); PG8_SCHED; PG8_LDA(At, 0, 0); PG8_STAGE(PG8_SA(1, 1), a1 + hstep, voffA);
            PG8_WAIT_V(8); PG8_WAIT_L(0); PG8_BAR; PG8_MMA(0, 0, At, B0); PG8_MMA(0, 1, At, B1); PG8_BAR; PG8_SCHED;
            PG8_LDA(At, 0, 1); PG8_STAGE(PG8_SB(0, 0), b2, voffB); PG8_STAGE(PG8_SB(0, 1), b2 + hstep, voffB); PG8_STAGE(PG8_SA(0, 0), a2, voffA);
            PG8_WAIT_V(8); PG8_WAIT_L(0); PG8_BAR; PG8_MMA(1, 0, At, B0); PG8_MMA(1, 1, At, B1); PG8_BAR; PG8_SCHED;
            PG8_LDB(B0, 1, 0); PG8_LDB(B1, 1, 1); PG8_SCHED; PG8_LDA(At, 1, 0); PG8_STAGE(PG8_SA(0, 1), a2 + hstep, voffA);
            PG8_WAIT_V(8); PG8_WAIT_L(0); PG8_BAR; PG8_MMA(0, 0, At, B0); PG8_MMA(0, 1, At, B1); PG8_BAR; PG8_SCHED;
            PG8_LDA(At, 1, 1); PG8_STAGE(PG8_SB(1, 0), b3, voffB); PG8_STAGE(PG8_SB(1, 1), b3 + hstep, voffB); PG8_STAGE(PG8_SA(1, 0), a3, voffA);
            PG8_WAIT_V(8); PG8_WAIT_L(0); PG8_BAR; PG8_MMA(1, 0, At, B0); PG8_MMA(1, 1, At, B1); PG8_BAR; PG8_SCHED;
            } else {
            PG8_LDB(B0, 0, 0); PG8_SCHED; PG8_LDA(At, 0, 0); PG8_STAGE(PG8_SA(1, 1), a1 + hstep, voffA);
            PG8_WAIT_L(8); PG8_BAR; PG8_WAIT_L(0); PG8_MMA(0, 0, At, B0); PG8_BAR; PG8_SCHED;
            PG8_LDB(B1, 0, 1); PG8_STAGE(PG8_SB(0, 0), b2, voffB);
            PG8_BAR; PG8_WAIT_L(0); PG8_MMA(0, 1, At, B1); PG8_BAR;
            PG8_LDA(At, 0, 1); PG8_STAGE(PG8_SA(0, 0), a2, voffA);
            PG8_BAR; PG8_WAIT_L(0); PG8_MMA(1, 0, At, B0); PG8_BAR; PG8_SCHED;
            PG8_STAGE(PG8_SB(0, 1), b2 + hstep, voffB);
            PG8_WAIT_V(6); PG8_BAR; PG8_MMA(1, 1, At, B1); PG8_BAR;
            PG8_LDB(B0, 1, 0); PG8_SCHED; PG8_LDA(At, 1, 0); PG8_STAGE(PG8_SA(0, 1), a2 + hstep, voffA);
            PG8_WAIT_L(8); PG8_BAR; PG8_WAIT_L(0); PG8_MMA(0, 0, At, B0); PG8_BAR; PG8_SCHED;
            PG8_LDB(B1, 1, 1); PG8_STAGE(PG8_SB(1, 0), b3, voffB);
            PG8_BAR; PG8_WAIT_L(0); PG8_MMA(0, 1, At, B1); PG8_BAR;
            PG8_LDA(At, 1, 1); PG8_STAGE(PG8_SA(1, 0), a3, voffA);
            PG8_BAR; PG8_WAIT_L(0); PG8_MMA(1, 0, At, B0); PG8_BAR; PG8_SCHED;
            PG8_STAGE(PG8_SB(1, 1), b3 + hstep, voffB);
            PG8_WAIT_V(6); PG8_BAR; PG8_MMA(1, 1, At, B1); PG8_BAR;
            }
        }
        if constexpr (ALIGN_EPI) { if (wr == 0) PG8_BAR; }
        E(acc, cur, wr, wc, fr, fq);
        if (!has_next) break;
#pragma unroll
        for (int a = 0; a < 2; ++a)
#pragma unroll
            for (int b = 0; b < 2; ++b)
#pragma unroll
                for (int m = 0; m < 4; ++m)
#pragma unroll
                    for (int n = 0; n < 2; ++n) acc[a][b][m][n] = (f32x4){0.f, 0.f, 0.f, 0.f};
        cur = nxt; cA = nA; cB = nB; ++ui;
        if constexpr (ALIGN_EPI) { if (wr == 1) PG8_BAR; }
    }
    PG8_WAIT_V(0);
    if constexpr (!ALIGN_EPI) { if (wr == 0) PG8_BAR; }
    PG8_BAR;
#undef PG8_SA
#undef PG8_SB
#undef PG8_STAGE
#undef PG8_LDA
#undef PG8_LDB
#undef PG8_MMA
#undef PG8_WAIT_V
#undef PG8_WAIT_L
#undef PG8_BAR
#undef PG8_SCHED
}
}
using pg8::Unit;

template <int NP> DI float row_rstd(const float* part, int row, int fq) {
    const float* p = part + (size_t)row * NP + fq * (NP / 4);
    float s = 0.f;
#pragma unroll
    for (int i = 0; i < NP / 4; i += 4) { const f32x4 v = *(const f32x4*)(p + i); s += (v[0] + v[1]) + (v[2] + v[3]); }
    s += __shfl_xor(s, 16); s += __shfl_xor(s, 32);
    return rsqrtf(s * (1.0f / 2048.0f) + RMS_EPS);
}

struct EpiIn {
    static constexpr bool PERM = true;
    const float* rstd0; bf16_t *qb, *kb, *vb, *ub, *gvb; float* gpart; float* out;
    DI void operator()(const f32x4 (&acc)[2][2][4][2], const Unit& u, int wr, int wc, int fr, int fq) const {
        const int pn = u.pn, rowb = u.pm * 256 + wr * 64 + fr, cw = wc * 32 + 8 * fq;
#pragma unroll
        for (int ai = 0; ai < 2; ++ai)
#pragma unroll
            for (int m = 0; m < 4; ++m) {
                const int row = rowb + ai * 128 + m * 16; const float rs = rstd0[row];
                if (pn < 4) {
#pragma unroll
                    for (int bj = 0; bj < 2; ++bj) *(u32x4*)(qb + (size_t)row * 1024 + pn * 256 + bj * 128 + cw) = pack8(acc[ai][bj][m][0] * rs, acc[ai][bj][m][1] * rs);
                } else if (pn == 4) {
#pragma unroll
                    for (int bj = 0; bj < 2; ++bj) {
                        const f32x4 v0 = acc[ai][bj][m][0] * rs, v1 = acc[ai][bj][m][1] * rs;
                        *(u32x4*)((bj ? vb : kb) + (size_t)row * 128 + cw) = pack8(v0, v1);
                        float* o = nullptr;
                        if (row >= MP) o = out + (bj ? O_VS : O_KS) + (size_t)(row - MP) * 128 + cw;
                        else if (row >= MP - 128) o = out + (bj ? O_VP : O_KP) + (size_t)(row - (MP - 128)) * 128 + cw;
                        if (o) { *(f32x4*)o = v0; *(f32x4*)(o + 4) = v1; }
                    }
                } else if (pn < 9) {
#pragma unroll
                    for (int bj = 0; bj < 2; ++bj) *(u32x4*)(ub + (size_t)row * 1024 + (pn - 5) * 256 + bj * 128 + cw) = pack8(gelu4(acc[ai][bj][m][0] * rs), gelu4(acc[ai][bj][m][1] * rs));
                } else {
                    float q = 0.f;
#pragma unroll
                    for (int bj = 0; bj < 2; ++bj) { const f32x4 v0 = gelu4(acc[ai][bj][m][0] * rs), v1 = gelu4(acc[ai][bj][m][1] * rs); q += sumsq4(v0) + sumsq4(v1);
                        *(u32x4*)(gvb + (size_t)row * 1024 + (pn - 9) * 256 + bj * 128 + cw) = pack8(v0, v1); }
                    q += __shfl_xor(q, 16); q += __shfl_xor(q, 32);
                    if (fq == 0) gpart[(size_t)row * 16 + (pn - 9) * 4 + wc] = q;
                }
            }
    }
};
struct EpiRes {
    static constexpr bool PERM = true;
    const float* base_p; const float* base_s; float* X; bf16_t* xb; float* part; bf16_t* pb; int nkt_full;
    DI void operator()(const f32x4 (&acc)[2][2][4][2], const Unit& u, int wr, int wc, int fr, int fq) const {
        if (pb && u.nkt != nkt_full) {
            bf16_t* t = pb + (size_t)u.aux * 65536 + (size_t)(wr * 64 + fr) * 256 + wc * 32 + 8 * fq;
#pragma unroll
            for (int ai = 0; ai < 2; ++ai)
#pragma unroll
                for (int m = 0; m < 4; ++m)
#pragma unroll
                    for (int bj = 0; bj < 2; ++bj) *(u32x4*)(t + (ai * 128 + m * 16) * 256 + bj * 128) = pack8(acc[ai][bj][m][0], acc[ai][bj][m][1]);
            return;
        }
        const int rowb = u.pm * 256 + wr * 64 + fr, cw = u.pn * 256 + wc * 32 + 8 * fq;
#pragma unroll
        for (int ai = 0; ai < 2; ++ai)
#pragma unroll
            for (int m = 0; m < 4; ++m) {
                const int row = rowb + ai * 128 + m * 16;
                const float* b = row < MP ? base_p + (size_t)row * DM : base_s + (size_t)(row - MP) * DM;
                float q = 0.f;
#pragma unroll
                for (int bj = 0; bj < 2; ++bj) { const int col = cw + bj * 128;
                    const f32x4 v0 = acc[ai][bj][m][0] + *(const f32x4*)(b + col), v1 = acc[ai][bj][m][1] + *(const f32x4*)(b + col + 4);
                    *(f32x4*)(X + (size_t)row * DM + col) = v0; *(f32x4*)(X + (size_t)row * DM + col + 4) = v1;
                    if (xb) *(u32x4*)(xb + (size_t)row * DM + col) = pack8(v0, v1);
                    q += sumsq4(v0) + sumsq4(v1); }
                q += __shfl_xor(q, 16); q += __shfl_xor(q, 32);
                if (fq == 0) part[(size_t)row * 32 + u.pn * 4 + wc] = q;
            }
    }
};
template <int NP> struct EpiSwiglu {
    static constexpr bool PERM = true;
    const float* part; bf16_t* act;
    DI void operator()(const f32x4 (&acc)[2][2][4][2], const Unit& u, int wr, int wc, int fr, int fq) const {
        const int rowb = u.pm * 256 + wr * 64 + fr, col = u.pn * 128 + wc * 32 + 8 * fq;
#pragma unroll
        for (int ai = 0; ai < 2; ++ai)
#pragma unroll
            for (int m = 0; m < 4; ++m) {
                const int row = rowb + ai * 128 + m * 16; const float rs = row_rstd<NP>(part, row, fq);
                f32x4 o[2];
#pragma unroll
                for (int n = 0; n < 2; ++n) { const f32x4 g = acc[ai][0][m][n] * rs, up = acc[ai][1][m][n] * rs;
#pragma unroll
                    for (int e = 0; e < 4; ++e) o[n][e] = g[e] * sigmoidf_(g[e]) * up[e]; }
                *(u32x4*)(act + (size_t)row * DFF + col) = pack8(o[0], o[1]);
            }
    }
};
struct EpiGlu {
    static constexpr bool PERM = true;
    float* X; bf16_t* xb; float* part;
    DI void operator()(const f32x4 (&acc)[2][2][4][2], const Unit& u, int wr, int wc, int fr, int fq) const {
        const int rowb = u.pm * 256 + wr * 64 + fr, col = u.pn * 128 + wc * 32 + 8 * fq;
#pragma unroll
        for (int ai = 0; ai < 2; ++ai)
#pragma unroll
            for (int m = 0; m < 4; ++m) {
                const int row = rowb + ai * 128 + m * 16; float* xp = X + (size_t)row * DM + col;
                f32x4 o[2];
#pragma unroll
                for (int n = 0; n < 2; ++n) { const f32x4 v = acc[ai][0][m][n], g = acc[ai][1][m][n]; const f32x4 b = *(const f32x4*)(xp + 4 * n);
#pragma unroll
                    for (int e = 0; e < 4; ++e) o[n][e] = b[e] + v[e] * sigmoidf_(g[e]); }
                *(f32x4*)xp = o[0]; *(f32x4*)(xp + 4) = o[1];
                *(u32x4*)(xb + (size_t)row * DM + col) = pack8(o[0], o[1]);
                float q = sumsq4(o[0]) + sumsq4(o[1]);
                q += __shfl_xor(q, 16); q += __shfl_xor(q, 32);
                if (fq == 0) part[(size_t)row * 64 + u.pn * 4 + wc] = q;
            }
    }
};

DI int fresh_tid() { int t; asm volatile("v_mov_b32 %0, %1" : "=v"(t) : "v"((int)threadIdx.x)); return t; }
struct Args { const float* in[27]; float* out; unsigned char* ws; };

DI float wave_sum(float v) {
#pragma unroll
    for (int o = 1; o < 64; o <<= 1) v += __shfl_xor(v, o);
    return v;
}

DI void tr_item(const float* W, int ldw, int k0, int c0, const float* gk, bf16_t* WT, int K, int drow0, LAS float* scr, int lane) {
    f32x4 v[8];
#pragma unroll
    for (int i = 0; i < 8; ++i) { const int k = 8 * i + (lane >> 3); v[i] = *(const f32x4*)(W + (size_t)(k0 + k) * ldw + c0 + (lane & 7) * 4); }
#pragma unroll
    for (int i = 0; i < 8; ++i) { const int k = 8 * i + (lane >> 3); const float sc = gk ? gk[k0 + k] : 1.0f; LAS float* d = scr + k * 33 + (lane & 7) * 4;
        d[0] = v[i][0] * sc; d[1] = v[i][1] * sc; d[2] = v[i][2] * sc; d[3] = v[i][3] * sc; }
    LDS_WAIT(); asm volatile("" ::: "memory");
    const int c = lane & 7;
#pragma unroll
    for (int j = 0; j < 4; ++j) { const int n = (lane >> 3) + 8 * j; const LAS float* s = scr + (8 * c) * 33 + n;
        u32x4 o; o.x = cvt_pk_bf16(s[0 * 33], s[1 * 33]); o.y = cvt_pk_bf16(s[2 * 33], s[3 * 33]); o.z = cvt_pk_bf16(s[4 * 33], s[5 * 33]); o.w = cvt_pk_bf16(s[6 * 33], s[7 * 33]);
        *(u32x4*)(WT + (size_t)(drow0 + n) * K + k0 + 8 * c) = o; }
    LDS_WAIT(); asm volatile("" ::: "memory");
}
DI void tr_mat(const float* W, int ldw, int csrc, int K, int N, const float* gk, bf16_t* WT, int inter, int half, LAS float* scr, int r, int lane) {
    const int nblk = N / 32, kb = r / nblk, nb = r % nblk, n0 = 32 * nb;
    const int drow0 = inter ? ((n0 >> 7) * 256 + half * 128 + (n0 & 127)) : n0;
    tr_item(W, ldw, 64 * kb, csrc + n0, gk, WT, K, drow0, scr, lane);
}

DI void sincos_f(float x, float& s, float& c) {
    const float n = rintf(x * 0.636619772367581343f);
    float r = fmaf(-n, 1.5703125f, x); r = fmaf(-n, 4.837512969970703125e-4f, r); r = fmaf(-n, 7.54978995489188216e-8f, r);
    const float z = r * r;
    const float sp = r + r * z * (-1.6666654611e-1f + z * (8.3321608736e-3f + z * (-1.9515295891e-4f)));
    const float cp = 1.0f - 0.5f * z + z * z * (4.166664568298827e-2f + z * (-1.388731625493765e-3f + z * 2.443315711809948e-5f));
    const int q = ((int)n) & 3;
    const float ss = (q & 1) ? cp : sp, cc = (q & 1) ? sp : cp;
    s = (q & 2) ? -ss : ss; c = ((q + 1) & 2) ? -cc : cc;
}

DI void attn_unit(LAS unsigned char* lds, int unit, const Args& A, const bf16_t* qb, const bf16_t* kb, const bf16_t* vb, bf16_t* omix, int tid, int wave, int lane) {
    LAS bf16_t* Ks = (LAS bf16_t*)lds;
    LAS bf16_t* Vt = (LAS bf16_t*)(lds + 27648);
    const int kh = unit & 1, cidx = unit >> 1; const bool samp = cidx >= 128; const int bs = cidx - 128;
    const float* ck = A.in[2]; const float* cv = A.in[3];
#pragma unroll
    for (int r = 0; r < 3; ++r) {
        const int idx = tid + 512 * r, key = idx >> 3, db = idx & 7;
        u32x4 kk = (u32x4){0u, 0u, 0u, 0u}, vv = (u32x4){0u, 0u, 0u, 0u};
        if (samp && key < 128) {
            const size_t o = ((size_t)(bs * 128 + key) * 2 + kh) * 64 + db * 8;
            kk = pack8(*(const f32x4*)(ck + o), *(const f32x4*)(ck + o + 4)); vv = pack8(*(const f32x4*)(cv + o), *(const f32x4*)(cv + o + 4));
        } else {
            const int row = samp ? (MP + bs * 64 + key - 128) : ((cidx - 2) * 64 + key);
            if (row >= 0) { kk = *(const u32x4*)(kb + (size_t)row * 128 + kh * 64 + db * 8); vv = *(const u32x4*)(vb + (size_t)row * 128 + kh * 64 + db * 8); }
        }
        *(LAS u32x4*)(Ks + key * 72 + db * 8) = kk;
#pragma unroll
        for (int e = 0; e < 4; ++e) { const unsigned w = vv[e]; Vt[(db * 8 + 2 * e) * 200 + key] = (bf16_t)(w & 0xffffu); Vt[(db * 8 + 2 * e + 1) * 200 + key] = (bf16_t)(w >> 16); }
    }
    __syncthreads();
    const int h = kh * 8 + wave, fr = lane & 15, quad = lane >> 4;
    const float slope = exp2f(-0.5f * (float)(h + 1)), sink = A.in[10][h];
    const int rowbase = samp ? (MP + bs * 64) : cidx * 64;
    const int kmin = samp ? 0 : (2 - cidx) * 64;
#pragma unroll 1
    for (int qt = 0; qt < 4; ++qt) {
        const int qrow = rowbase + qt * 16 + fr;
        bf16x8 bq[2];
#pragma unroll
        for (int ks = 0; ks < 2; ++ks) bq[ks] = *(const bf16x8*)(qb + (size_t)qrow * 1024 + h * 64 + ks * 32 + quad * 8);
        f32x4 s[12];
#pragma unroll
        for (int kt = 0; kt < 12; ++kt) { f32x4 a = (f32x4){0.f, 0.f, 0.f, 0.f};
#pragma unroll
            for (int ks = 0; ks < 2; ++ks) { const bf16x8 ak = *(const LAS bf16x8*)(Ks + (kt * 16 + fr) * 72 + ks * 32 + quad * 8); a = __builtin_amdgcn_mfma_f32_16x16x32_bf16(ak, bq[ks], a, 0, 0, 0); }
            s[kt] = a; if (kt & 1) __builtin_amdgcn_sched_barrier(0); }
        const int qi = qt * 16 + fr;
        float mx = -1e30f;
#pragma unroll
        for (int kt = 0; kt < 12; ++kt)
#pragma unroll
            for (int j = 0; j < 4; ++j) { const int ki = kt * 16 + quad * 4 + j; const int d = 128 + qi - ki; const float dist = (float)(d < 0 ? -d : d);
                float v = s[kt][j] * 0.125f - slope * dist; if (ki < kmin) v = -1e30f; s[kt][j] = v; mx = fmaxf(mx, v); }
        mx = fmaxf(mx, __shfl_xor(mx, 16)); mx = fmaxf(mx, __shfl_xor(mx, 32)); mx = fmaxf(mx, sink);
        float sum = 0.f;
#pragma unroll
        for (int kt = 0; kt < 12; ++kt)
#pragma unroll
            for (int j = 0; j < 4; ++j) { const float p = __expf(s[kt][j] - mx); s[kt][j] = p; sum += p; }
        sum += __shfl_xor(sum, 16); sum += __shfl_xor(sum, 32);
        const float inv = 1.0f / (sum + __expf(sink - mx));
        f32x4 o[4];
#pragma unroll
        for (int dt = 0; dt < 4; ++dt) o[dt] = (f32x4){0.f, 0.f, 0.f, 0.f};
#pragma unroll
        for (int s2 = 0; s2 < 6; ++s2) {
            const u32x4 bpw = pack8(s[2 * s2] * inv, s[2 * s2 + 1] * inv); const bf16x8 bp = __builtin_bit_cast(bf16x8, bpw);
#pragma unroll
            for (int dt = 0; dt < 4; ++dt) {
                const LAS bf16_t* vp = Vt + (dt * 16 + fr) * 200 + s2 * 32 + quad * 4;
                const u32x2 lo = *(const LAS u32x2*)vp, hi = *(const LAS u32x2*)(vp + 16);
                const u32x4 avw = (u32x4){lo.x, lo.y, hi.x, hi.y};
                o[dt] = __builtin_amdgcn_mfma_f32_16x16x32_bf16(__builtin_bit_cast(bf16x8, avw), bp, o[dt], 0, 0, 0);
            }
            __builtin_amdgcn_sched_barrier(0);
        }
#pragma unroll
        for (int dt = 0; dt < 4; ++dt) *(u32x2*)(omix + (size_t)qrow * DM + h * 64 + dt * 16 + quad * 4) = pack4(o[dt]);
    }
    __syncthreads();
}

DI void gm_unit(LAS unsigned char* lds, int unit, const Args& A, const bf16_t* ub, const bf16_t* gvb, const float* gpart, const bf16_t* wmb, bf16_t* omix, int tid, int wave, int lane) {
    LAS bf16_t* vT = (LAS bf16_t*)lds;
    const bool samp = unit >= 1024; const int g = unit & 15;
    const int r0 = samp ? (MP + ((unit - 1024) >> 4) * 64) : ((unit >> 4) * 128), T = samp ? 64 : 128;
    {
        const int s = tid >> 2, dq = tid & 3;
        if (s < T) {
            const int row = r0 + s;
            const f32x4 pp = *(const f32x4*)(gpart + (size_t)row * 16 + dq * 4);
            float ss = (pp[0] + pp[1]) + (pp[2] + pp[3]); ss += __shfl_xor(ss, 1); ss += __shfl_xor(ss, 2);
            const float rs = rsqrtf(ss * (1.0f / 1024.0f) + RMS_EPS);
            const int c0 = g * 64 + dq * 16;
            const u32x4 w0 = *(const u32x4*)(gvb + (size_t)row * 1024 + c0), w1 = *(const u32x4*)(gvb + (size_t)row * 1024 + c0 + 8);
            const float* gn = A.in[11] + c0;
            float val[16];
#pragma unroll
            for (int e = 0; e < 4; ++e) { val[2 * e] = bf2f(w0[e] & 0xffffu); val[2 * e + 1] = bf2f(w0[e] >> 16); val[8 + 2 * e] = bf2f(w1[e] & 0xffffu); val[8 + 2 * e + 1] = bf2f(w1[e] >> 16); }
#pragma unroll
            for (int e = 0; e < 16; ++e) val[e] = val[e] * rs * gn[e];
            if (samp) { float* o = A.out + O_GV + (size_t)(row - MP) * 1024 + c0;
#pragma unroll
                for (int e = 0; e < 4; ++e) *(f32x4*)(o + 4 * e) = (f32x4){val[4 * e], val[4 * e + 1], val[4 * e + 2], val[4 * e + 3]}; }
#pragma unroll
            for (int e = 0; e < 16; ++e) vT[(dq * 16 + e) * 136 + s] = (bf16_t)f2bf(val[e]);
        }
    }
    __syncthreads();
    const int tt = wave, fr = lane & 15, quad = lane >> 4;
    if (tt * 16 < T) {
        const int t = tt * 16 + fr, row = r0 + t;
        const bool lowhalf = tt < 4;
        bf16x8 bw[4];
#pragma unroll
        for (int ks = 0; ks < 4; ++ks) bw[ks] = (ks < 2 || !lowhalf) ? *(const bf16x8*)(wmb + ((size_t)(g * 128 + t)) * 128 + ks * 32 + quad * 8) : (bf16x8){0, 0, 0, 0, 0, 0, 0, 0};
        const float bias = A.in[13][g * 128 + t];
#pragma unroll
        for (int dt = 0; dt < 4; ++dt) {
            f32x4 acc = (f32x4){0.f, 0.f, 0.f, 0.f};
#pragma unroll
            for (int ks = 0; ks < 4; ++ks) if (ks < 2 || !lowhalf) {
                const bf16x8 a = *(const LAS bf16x8*)(vT + (dt * 16 + fr) * 136 + ks * 32 + quad * 8);
                acc = __builtin_amdgcn_mfma_f32_16x16x32_bf16(a, bw[ks], acc, 0, 0, 0); }
            const int c = g * 64 + dt * 16 + quad * 4;
            const u32x2 uw = *(const u32x2*)(ub + (size_t)row * 1024 + c);
            f32x4 o; o[0] = bf2f(uw.x & 0xffffu) * (acc[0] + bias); o[1] = bf2f(uw.x >> 16) * (acc[1] + bias); o[2] = bf2f(uw.y & 0xffffu) * (acc[2] + bias); o[3] = bf2f(uw.y >> 16) * (acc[3] + bias);
            *(u32x2*)(omix + (size_t)row * DM + 1024 + c) = pack4(o);
        }
    }
    __syncthreads();
}

template <bool FULL> DI void s5_item(LAS unsigned char* wl, int cidx, int g, bool newchunk, int lane, const Args& A, const float* X, const float* part, const float* s5a, const bf16_t* bbcat, const bf16_t* ccat, float* E, bf16_t* yb) {
    LAS float* bu = (LAS float*)wl;
    LAS bf16_t* sb = (LAS bf16_t*)(wl + 8448);
    LAS float* rsl = (LAS float*)(wl + 8448 + 4352);
    const bool samp = cidx >= 128; const int rowbase = samp ? MP + (cidx - 128) * 64 : cidx * 64;
    if (newchunk) {
        const float* pp = part + (size_t)(rowbase + lane) * 32; float s = 0.f;
#pragma unroll
        for (int i = 0; i < 32; i += 4) { const f32x4 v = *(const f32x4*)(pp + i); s += (v[0] + v[1]) + (v[2] + v[3]); }
        rsl[lane] = rsqrtf(s * (1.0f / 2048.0f) + RMS_EPS);
    }
    const int fr = lane & 15, quad = lane >> 4;
    const bf16x8 zero8 = (bf16x8){0, 0, 0, 0, 0, 0, 0, 0};
    bf16x8 bbf[8];
#pragma unroll
    for (int nt = 0; nt < 8; ++nt) bbf[nt] = quad < 2 ? *(const bf16x8*)(bbcat + ((size_t)(g * 128 + nt * 16 + fr)) * 16 + quad * 8) : zero8;
    bf16x8 ccf[4];
    if (FULL) {
#pragma unroll
        for (int ks = 0; ks < 4; ++ks) ccf[ks] = *(const bf16x8*)(ccat + ((size_t)(g * 16 + fr)) * 128 + ks * 32 + quad * 8);
    }
    const float are = s5a[g * 64 + lane], aim = s5a[8192 + g * 64 + lane];
    float sre = 0.f, sim = 0.f;
    if (FULL) {
        if (samp) { const size_t o = ((size_t)(cidx - 128) * 128 + g) * 64 + lane; sre = A.in[4][o]; sim = A.in[5][o]; }
        else {
            const f32x2 e = *(const f32x2*)(E + ((size_t)(cidx * 128 + g) * 64 + lane) * 2); sre = e.x; sim = e.y;
        }
    }
    const float* gmix = A.in[6] + DM + g * 16;
    const f32x4 g0 = *(const f32x4*)(gmix + (quad & 1) * 8), g1 = *(const f32x4*)(gmix + (quad & 1) * 8 + 4);
    f32x4 gm = g0, dk = g0;
    if (FULL) { gm = *(const f32x4*)(gmix + quad * 4); dk = *(const f32x4*)(A.in[22] + g * 16 + quad * 4); }
#define S5_LOAD(sub_, a0, a1, av) do { const float* xr_ = X + (size_t)(rowbase + (sub_) * 16 + fr) * DM + g * 16; \
        if (quad < 2) { a0 = *(const f32x4*)(xr_ + quad * 8); a1 = *(const f32x4*)(xr_ + quad * 8 + 4); } if (FULL) av = *(const f32x4*)(xr_ + quad * 4); } while (0)
    const f32x4 z4 = (f32x4){0.f, 0.f, 0.f, 0.f};
    f32x4 n0 = z4, n1 = z4, nv = z4;
    S5_LOAD(0, n0, n1, nv);
    LDS_WAIT(); asm volatile("" ::: "memory");
#pragma unroll 1
    for (int sub = 0; sub < 4; ++sub) {
        const int row = rowbase + sub * 16 + fr; const float rr = rsl[sub * 16 + fr];
        const f32x4 c0 = n0, c1 = n1, cv = nv;
        if (sub < 3) S5_LOAD(sub + 1, n0, n1, nv);
        bf16x8 ua = zero8;
        if (quad < 2) ua = __builtin_bit_cast(bf16x8, pack8(c0 * g0 * rr, c1 * g1 * rr));
#pragma unroll
        for (int nt = 0; nt < 8; ++nt) { const f32x4 a = __builtin_amdgcn_mfma_f32_16x16x32_bf16(ua, bbf[nt], (f32x4){0.f, 0.f, 0.f, 0.f}, 0, 0, 0);
#pragma unroll
            for (int j = 0; j < 4; ++j) bu[(quad * 4 + j) * 132 + nt * 16 + fr] = a[j]; }
        LDS_WAIT(); asm volatile("" ::: "memory");
#pragma unroll
        for (int t = 0; t < 16; ++t) { const float re = bu[t * 132 + lane], im = bu[t * 132 + 64 + lane];
            const float nre = are * sre - aim * sim + re, nim = are * sim + aim * sre + im; sre = nre; sim = nim;
            if (FULL) { const unsigned w = cvt_pk_bf16(sre, sim); sb[t * 136 + lane] = (bf16_t)(w & 0xffffu); sb[t * 136 + 64 + lane] = (bf16_t)(w >> 16); } }
        if (FULL) {
            LDS_WAIT(); asm volatile("" ::: "memory");
            f32x4 y = (f32x4){0.f, 0.f, 0.f, 0.f};
#pragma unroll
            for (int ks = 0; ks < 4; ++ks) { const bf16x8 sf = *(const LAS bf16x8*)(sb + fr * 136 + ks * 32 + quad * 8); y = __builtin_amdgcn_mfma_f32_16x16x32_bf16(ccf[ks], sf, y, 0, 0, 0); }
            const f32x4 hh = cv * gm * rr;
            *(u32x2*)(yb + (size_t)row * DM + g * 16 + quad * 4) = pack4(gelu4(y + dk * hh));
        }
        LDS_WAIT(); asm volatile("" ::: "memory");
    }
#undef S5_LOAD
    if (FULL) {
        if (samp) { const size_t o = ((size_t)(cidx - 128) * 128 + g) * 64 + lane; A.out[O_SSR + o] = sre; A.out[O_SSI + o] = sim; }
        else if (cidx == 127) { A.out[O_SPR + g * 64 + lane] = sre; A.out[O_SPI + g * 64 + lane] = sim; }
    } else {
        *(f32x2*)(E + ((size_t)(cidx * 128 + g) * 64 + lane) * 2) = (f32x2){sre, sim};
    }
}

DI f32x4 pb_sum(const bf16_t* pb, int r, int col) {
    const int su = (r >> 8) * 8 + (col >> 8); const bf16_t* p = pb + (size_t)su * 8 * 65536 + (size_t)(r & 255) * 256 + (col & 255);
    f32x4 s = (f32x4){0.f, 0.f, 0.f, 0.f};
#pragma unroll
    for (int pc = 0; pc < 8; ++pc) { const u32x2 w = *(const u32x2*)(p + (size_t)pc * 65536);
        s += (f32x4){bf2f(w.x & 0xffffu), bf2f(w.x >> 16), bf2f(w.y & 0xffffu), bf2f(w.y >> 16)}; }
    return s;
}
constexpr int CV_IN = 32 * 104, CV_OUT = 32 * 64, CV_G = 32 * 176, CV_D = 88 * 64, CV_GL = 32 * 64;
constexpr int CV_A1 = CV_IN, CV_A2 = CV_A1 + CV_OUT, CV_A3 = CV_A2 + 2 * CV_G, CV_A4 = CV_A3 + 2 * CV_GL, CV_A5 = CV_A4 + CV_D, CV_A6 = CV_A5 + 2 * CV_G, CV_A7 = CV_A6 + CV_D;
DI void conv_items(const Args& A, unsigned char* ws, int first, int last, int worker, int nworkers, LAS float* scr, int lane, bool skip_early) {
    const float* nmix = A.in[6]; const float* nffn = A.in[7];
    bf16_t* Wt_in = (bf16_t*)(ws + WS_WIN); bf16_t* Wt_out = (bf16_t*)(ws + WS_WOUT); bf16_t* Wt_gu0 = (bf16_t*)(ws + WS_WGU0); bf16_t* Wt_d0 = (bf16_t*)(ws + WS_WD0);
    bf16_t* Wt_glu = (bf16_t*)(ws + WS_WGLU); bf16_t* Wt_gu1 = (bf16_t*)(ws + WS_WGU1); bf16_t* Wt_d1 = (bf16_t*)(ws + WS_WD1);
    for (int it = first + worker; it < last; it += nworkers) {
        int r = it;
        if (r < CV_IN) { tr_mat(A.in[9], DIN0, 0, DM, DIN0, nmix, Wt_in, 0, 0, scr, r, lane); continue; } r -= CV_IN;
        if (r < CV_OUT) { tr_mat(A.in[14], DM, 0, DM, DM, nullptr, Wt_out, 0, 0, scr, r, lane); continue; } r -= CV_OUT;
        if (r < CV_G) { if (!(skip_early && (r % 176) < 8)) tr_mat(A.in[24], DFF, 0, DM, DFF, nffn, Wt_gu0, 1, 0, scr, r, lane); continue; } r -= CV_G;
        if (r < CV_G) { if (!(skip_early && (r % 176) < 8)) tr_mat(A.in[25], DFF, 0, DM, DFF, nffn, Wt_gu0, 1, 1, scr, r, lane); continue; } r -= CV_G;
        if (r < CV_GL) { tr_mat(A.in[23], 2 * DM, 0, DM, DM, nullptr, Wt_glu, 1, 0, scr, r, lane); continue; } r -= CV_GL;
        if (r < CV_GL) { tr_mat(A.in[23], 2 * DM, DM, DM, DM, nullptr, Wt_glu, 1, 1, scr, r, lane); continue; } r -= CV_GL;
        if (r < CV_D) { tr_mat(A.in[26], DM, 0, DFF, DM, nullptr, Wt_d0, 0, 0, scr, r, lane); continue; } r -= CV_D;
        if (r < CV_G) { if (!(skip_early && (r % 176) < 8)) tr_mat(A.in[24] + (size_t)DM * DFF, DFF, 0, DM, DFF, nffn + DM, Wt_gu1, 1, 0, scr, r, lane); continue; } r -= CV_G;
        if (r < CV_G) { if (!(skip_early && (r % 176) < 8)) tr_mat(A.in[25] + (size_t)DM * DFF, DFF, 0, DM, DFF, nffn + DM, Wt_gu1, 1, 1, scr, r, lane); continue; } r -= CV_G;
        tr_mat(A.in[26] + (size_t)DFF * DM, DM, 0, DFF, DM, nullptr, Wt_d1, 0, 0, scr, r, lane);
    }
}
DI void conv_early(const Args& A, unsigned char* ws, int worker, int nworkers, LAS float* scr, int lane) {
    const float* nffn = A.in[7];
    for (int e = worker; e < 1024; e += nworkers) {
        const int lay = e >> 9, mat = (e >> 8) & 1, kb = (e & 255) >> 3, nb = e & 7;
        tr_mat(A.in[24 + mat] + (size_t)lay * DM * DFF, DFF, 0, DM, DFF, nffn + lay * DM, (bf16_t*)(ws + (lay ? WS_WGU1 : WS_WGU0)), 1, mat, scr, kb * 176 + nb, lane);
    }
}
#define XB_TMO      128
#define XB_XCNT(j)  (256  + 64 * (j))
#define XB_XSUB(j)  (1280 + 64 * (j))
#define XB_XGEN(j)  (2304 + 64 * (j))
#define XB_TOP      3328
#define XB_TOPGEN   3392
#define XCD_BAR_WORDS 3456
#define XB_SPIN_CAP (1u << 18)
DI unsigned xb_ld(unsigned* p)              { return __hip_atomic_load(p, __ATOMIC_RELAXED, __HIP_MEMORY_SCOPE_AGENT); }
DI unsigned xb_add(unsigned* p, unsigned v) { return __hip_atomic_fetch_add(p, v, __ATOMIC_RELAXED, __HIP_MEMORY_SCOPE_AGENT); }
DI unsigned xb_xcc_id() { return (unsigned)__builtin_amdgcn_s_getreg((3 << 11) | 20) & 0xFu; }
#define XB_SPIN(cond, bar) do { unsigned _sp = 0; while (cond) { __builtin_amdgcn_s_sleep(1); \
    if ((++_sp & 255u) == 0u) { if (xb_ld(&(bar)[XB_TMO])) break; if (_sp > XB_SPIN_CAP) { atomicAdd(&(bar)[XB_TMO], 1u); break; } } } } while (0)
struct XcdBarrier { unsigned* bar; unsigned x; volatile LAS unsigned* st; };
DI XcdBarrier xcd_barrier_post(unsigned* bar, volatile LAS unsigned* st) {
    XcdBarrier b; b.bar = bar; b.x = xb_xcc_id(); b.st = st;
    if (threadIdx.x == 0) (void)xb_add(&bar[XB_XCNT(b.x)], 1u);
    return b;
}
DI void xcd_barrier_complete(unsigned* bar, unsigned x, unsigned& nloc, unsigned& nx) {
    const unsigned G = gridDim.x * gridDim.y * gridDim.z;
    unsigned sum, cnt, mine, sp = 0u;
    for (;;) {
        sum = 0u; cnt = 0u; mine = 0u;
#pragma unroll
        for (unsigned j = 0; j < 16; ++j) { const unsigned c = xb_ld(&bar[XB_XCNT(j)]); sum += c; cnt += (c > 0u) ? 1u : 0u; mine = (j == x) ? c : mine; }
        if (sum == G) break;
        __builtin_amdgcn_s_sleep(1);
        if ((++sp & 255u) == 0u) { if (xb_ld(&bar[XB_TMO])) break; if (sp > XB_SPIN_CAP) { atomicAdd(&bar[XB_TMO], 1u); break; } }
    }
    nloc = mine > 0u ? mine : 1u; nx = cnt > 0u ? cnt : 1u;
}
DI void xcd_barrier(const XcdBarrier& b) {
    asm volatile("s_waitcnt vmcnt(0)" ::: "memory");
    __syncthreads();
    if (threadIdx.x == 0) {
        unsigned* bar = b.bar;
        __builtin_amdgcn_s_waitcnt(0);
        unsigned nloc = b.st[0], nx = b.st[1];
        if (nloc == 0u) { xcd_barrier_complete(bar, b.x, nloc, nx); b.st[0] = nloc; b.st[1] = nx; }
        const unsigned old = xb_add(&bar[XB_XSUB(b.x)], 1u);
        const unsigned gen = old / nloc;
        if (old + 1u == (gen + 1u) * nloc) {
            __builtin_amdgcn_fence(__ATOMIC_RELEASE, "agent");
            asm volatile("s_waitcnt vmcnt(0)" ::: "memory");
            const unsigned og = xb_add(&bar[XB_TOP], 1u);
            const unsigned tg = og / nx;
            if (og + 1u == (tg + 1u) * nx) xb_add(&bar[XB_TOPGEN], 1u);
            else XB_SPIN(xb_ld(&bar[XB_TOPGEN]) == tg, bar);
            __builtin_amdgcn_fence(__ATOMIC_ACQUIRE, "agent");
            xb_add(&bar[XB_XGEN(b.x)], 1u);
            asm volatile("s_waitcnt vmcnt(0)" ::: "memory");
        } else {
            XB_SPIN(xb_ld(&bar[XB_XGEN(b.x)]) == gen, bar);
            __builtin_amdgcn_fence(__ATOMIC_ACQUIRE, "agent");
            asm volatile("s_waitcnt vmcnt(0)" ::: "memory");
        }
    }
    __syncthreads();
}
#define GSYNC() do { asm volatile("s_waitcnt vmcnt(0)" ::: "memory"); grid.sync(); asm volatile("s_waitcnt vmcnt(0)" ::: "memory"); __syncthreads(); } while (0)
#define CONV_TAIL(nu, first, last) do { const int _r = (nu) % G; \
    if (_r != 0) { if (bx >= _r) conv_items(A, ws, (first), (last), (bx - _r) * 8 + wave, (G - _r) * 8, (LAS float*)(lds + wave * 16384), fresh_tid() & 63, false); } \
    else conv_items(A, ws, (first), (last), gw, NGW, (LAS float*)(lds + wave * 16384), fresh_tid() & 63, false); } while (0)
__global__ void __launch_bounds__(512, 2) mega_fwd(Args A) {
    extern __shared__ __attribute__((aligned(16))) unsigned char lds_raw[];
    LAS unsigned char* lds = (LAS unsigned char*)lds_raw;
    cg::grid_group grid = cg::this_grid();
    const int wave = __builtin_amdgcn_readfirstlane((int)threadIdx.x >> 6);
    const int G = gridDim.x, bx = blockIdx.x, gw = bx * 8 + wave, NGW = G * 8, NGT = G * 512;
    unsigned char* ws = A.ws;
    float* rstd0 = (float*)(ws + WS_RSTD0); float* gpart = (float*)(ws + WS_GPART); float* part = (float*)(ws + WS_PART);
    float* s5a = (float*)(ws + WS_S5A); bf16_t* bbcat = (bf16_t*)(ws + WS_BBCAT); bf16_t* ccat = (bf16_t*)(ws + WS_CCAT); bf16_t* wmb = (bf16_t*)(ws + WS_WMB);
    float* E = (float*)(ws + WS_E);
    bf16_t* Wt_in = (bf16_t*)(ws + WS_WIN); bf16_t* Wt_out = (bf16_t*)(ws + WS_WOUT); bf16_t* Wt_gu0 = (bf16_t*)(ws + WS_WGU0); bf16_t* Wt_d0 = (bf16_t*)(ws + WS_WD0);
    bf16_t* Wt_glu = (bf16_t*)(ws + WS_WGLU); bf16_t* Wt_gu1 = (bf16_t*)(ws + WS_WGU1); bf16_t* Wt_d1 = (bf16_t*)(ws + WS_WD1);
    bf16_t* XB = (bf16_t*)(ws + WS_XB); bf16_t* ACT = (bf16_t*)(ws + WS_R);
    bf16_t* qb = (bf16_t*)(ws + WS_QB); bf16_t* ub = (bf16_t*)(ws + WS_UB); bf16_t* gvb = (bf16_t*)(ws + WS_GVB); bf16_t* kb = (bf16_t*)(ws + WS_KB); bf16_t* vb = (bf16_t*)(ws + WS_VB);
    bf16_t* omix = (bf16_t*)(ws + WS_OMIX); bf16_t* yb = (bf16_t*)(ws + WS_YB);
    if (threadIdx.x < 2) ((volatile LAS unsigned*)(lds + 131072))[threadIdx.x] = 0u;
    __syncthreads();
    const XcdBarrier xbar = xcd_barrier_post((unsigned*)(ws + WS_BAR), (volatile LAS unsigned*)(lds + 131072));
const bool fastbar = (gridDim.x == 256);
#define XSYNC() do { if (fastbar) xcd_barrier(xbar); else GSYNC(); } while (0)
    bf16_t* PB = (bf16_t*)(ws + WS_PB);
    float* X = A.out;

    for (int rep = 0; rep <= DUP_P0; ++rep) {
        const int tid = fresh_tid(), lane = tid & 63, gt = bx * 512 + tid;
        LAS float* scr = (LAS float*)(lds + wave * 16384);
        conv_items(A, ws, 0, CV_A1, gw, NGW, scr, lane, false);
        for (int row = gw; row < MTOK; row += NGW) {
            const float* xr = row < MP ? A.in[0] + (size_t)row * DM : A.in[1] + (size_t)(row - MP) * DM;
            f32x4 v[8]; float s = 0.f;
#pragma unroll
            for (int j = 0; j < 8; ++j) { v[j] = *(const f32x4*)(xr + (lane + 64 * j) * 4); s += sumsq4(v[j]); }
            s = wave_sum(s);
            if (lane == 0) rstd0[row] = rsqrtf(s * (1.0f / 2048.0f) + RMS_EPS);
#pragma unroll
            for (int j = 0; j < 8; ++j) *(u32x2*)(XB + (size_t)row * DM + (lane + 64 * j) * 4) = pack4(v[j]);
        }
        for (int idx = gt; idx < 8192; idx += NGT) {
            const int g = idx >> 6;
            const float dt = expf(A.in[17][g]), lr = A.in[15][idx], li = A.in[16][idx];
            const float mag = expf(lr * dt); float sn, cs; sincos_f(li * dt, sn, cs);
            const float are = mag * cs, aim = mag * sn, den = lr * lr + li * li, nr = are - 1.0f;
            const float fre = (nr * lr + aim * li) / den, fim = (aim * lr - nr * li) / den;
            const int p = idx & 63;
#pragma unroll
            for (int i = 0; i < 16; ++i) { const float br = A.in[18][(size_t)idx * 16 + i], bi = A.in[19][(size_t)idx * 16 + i];
                bbcat[((size_t)(g * 128 + p)) * 16 + i] = (bf16_t)f2bf(fre * br - fim * bi); bbcat[((size_t)(g * 128 + 64 + p)) * 16 + i] = (bf16_t)f2bf(fre * bi + fim * br); }
            float pr = are, pi = aim;
#pragma unroll
            for (int k = 0; k < 6; ++k) { const float t0 = pr * pr - pi * pi, t1 = 2.0f * pr * pi; pr = t0; pi = t1; }
            s5a[idx] = are; s5a[8192 + idx] = aim; s5a[16384 + idx] = pr; s5a[24576 + idx] = pi;
        }
        for (int idx = gt; idx < 128 * 16 * 64; idx += NGT) {
            const int p = idx & 63, gi = idx >> 6;
            ccat[(size_t)gi * 128 + p] = (bf16_t)f2bf(A.in[20][idx]); ccat[(size_t)gi * 128 + 64 + p] = (bf16_t)f2bf(-A.in[21][idx]);
        }
        for (int idx = gt; idx < 16 * 128 * 128; idx += NGT) {
            const int s = idx & 127, t = (idx >> 7) & 127;
            wmb[idx] = ((t >> 6) >= (s >> 6)) ? (bf16_t)f2bf(A.in[12][idx]) : (bf16_t)0;
        }
    }
    XSYNC();
    {
        pg8::Gemm g{XB, Wt_in, MTOK, DIN0, DM}; pg8::StaticOrder S; S.init(MTOK, DIN0, G, bx);
        EpiIn Ep{rstd0, qb, kb, vb, ub, gvb, gpart, A.out};
        pg8::gemm_phase<EpiIn, pg8::StaticOrder, true, true>(lds, g, S, Ep);
        CONV_TAIL((MTOK / 256) * (DIN0 / 256), CV_A1, CV_A2);
        if (G == 256 && bx >= 212) conv_early(A, ws, (bx - 212) * 8 + wave, 44 * 8, (LAS float*)(lds + wave * 16384), fresh_tid() & 63);
    }
    XSYNC();
    if (G == 256) {
        const int tid = fresh_tid(), lane = tid & 63;
        attn_unit(lds, bx, A, qb, kb, vb, omix, tid, wave, lane);
        if (bx < 32) { attn_unit(lds, 256 + bx, A, qb, kb, vb, omix, tid, wave, lane);
            gm_unit(lds, 1120 + 2 * bx, A, ub, gvb, gpart, wmb, omix, tid, wave, lane); gm_unit(lds, 1121 + 2 * bx, A, ub, gvb, gpart, wmb, omix, tid, wave, lane); }
        else {
#pragma unroll 1
            for (int k = 0; k < 5; ++k) gm_unit(lds, (bx - 32) + 224 * k, A, ub, gvb, gpart, wmb, omix, tid, wave, lane);
            if (bx < 128) gm_unit(lds, 1184 + (bx - 32), A, ub, gvb, gpart, wmb, omix, tid, wave, lane);
        }
    } else
    for (int u = bx; u < 288 + 1280; u += G) {
        const int tid = fresh_tid(), lane = tid & 63;
        if (u < 288) attn_unit(lds, u, A, qb, kb, vb, omix, tid, wave, lane);
        else gm_unit(lds, u - 288, A, ub, gvb, gpart, wmb, omix, tid, wave, lane);
    }
    XSYNC();
    if (G == 256) {
        pg8::Gemm g{omix, Wt_out, MTOK, DM, DM}; EpiRes Ep{A.in[0], A.in[1], X, XB, part, nullptr, 0};
        { pg8::StaticOrder S; S.init(MP, DM, G, bx); pg8::gemm_phase<EpiRes, pg8::StaticOrder, true, true>(lds, g, S, Ep); }
        XSYNC();
        if (bx < 32) { pg8::OneUnit S{32 + (bx >> 3), bx & 7}; pg8::gemm_phase<EpiRes, pg8::OneUnit, true, true>(lds, g, S, Ep); }
        else if (bx < 80) { const int e = bx - 32; pg8::OneUnit S{pg8::early_panel(0, e >> 1), e & 1}; pg8::Gemm g4{XB, Wt_gu0, MTOK, 2 * DFF, DM}; EpiSwiglu<32> E4{part, ACT};
            pg8::gemm_phase<EpiSwiglu<32>, pg8::OneUnit, true, true>(lds, g4, S, E4); }
        else conv_items(A, ws, CV_A2, CV_A4, (bx - 80) * 8 + wave, 176 * 8, (LAS float*)(lds + wave * 16384), fresh_tid() & 63, true);
    } else {
        pg8::Gemm g{omix, Wt_out, MTOK, DM, DM}; pg8::StaticOrder S; S.init(MTOK, DM, G, bx);
        EpiRes Ep{A.in[0], A.in[1], X, XB, part, nullptr, 0};
        pg8::gemm_phase<EpiRes, pg8::StaticOrder, true, true>(lds, g, S, Ep);
        CONV_TAIL((MTOK / 256) * (DM / 256), CV_A2, CV_A3);
    }
    XSYNC();
    {
        pg8::Gemm g{XB, Wt_gu0, MTOK, 2 * DFF, DM}; EpiSwiglu<32> Ep{part, ACT};
        if (G == 256) { pg8::SkipOrder S; S.init(G, bx, 0); pg8::gemm_phase<EpiSwiglu<32>, pg8::SkipOrder, true, true>(lds, g, S, Ep);
            conv_items(A, ws, CV_A4, CV_A5, gw, NGW, (LAS float*)(lds + wave * 16384), fresh_tid() & 63, false); }
        else { pg8::StaticOrder S; S.init(MTOK, 2 * DFF, G, bx); pg8::gemm_phase<EpiSwiglu<32>, pg8::StaticOrder, true, true>(lds, g, S, Ep);
            CONV_TAIL((MTOK / 256) * (2 * DFF / 256), CV_A3, CV_A5); }
    }
    XSYNC();
    {
        pg8::Gemm g{ACT, Wt_d0, MTOK, DM, DFF};
        if (G == 256) { pg8::SplitOrder S; S.init(DFF, bx); EpiRes Ep{X, X + (size_t)MP * DM, X, nullptr, part, PB, DFF / 64};
            pg8::gemm_phase<EpiRes, pg8::SplitOrder, true, true>(lds, g, S, Ep); }
        else { pg8::StaticOrder S; S.init(MTOK, DM, G, bx); EpiRes Ep{X, X + (size_t)MP * DM, X, nullptr, part, nullptr, 0};
            pg8::gemm_phase<EpiRes, pg8::StaticOrder, true, true>(lds, g, S, Ep); }
    }
    XSYNC();
    for (int rep = 0; rep <= DUP_P6; ++rep) {
        const int lane = fresh_tid() & 63;
        if (G == 256 && rep == 0) {
            const int r = gw >> 1, half = gw & 1;
            float* xr = X + (size_t)(MP + r) * DM + half * 1024; float sq = 0.f;
#pragma unroll
            for (int j = 0; j < 4; ++j) { const int col = (lane + 64 * j) * 4; const f32x4 v = *(const f32x4*)(xr + col) + pb_sum(PB, r, half * 1024 + col); *(f32x4*)(xr + col) = v; sq += sumsq4(v); }
            sq = wave_sum(sq);
            if (lane < 16) part[(size_t)(MP + r) * 32 + 2 * lane + half] = lane == 0 ? sq : 0.f;
        }
        LAS unsigned char* wl = lds + wave * 16384;
        { const int per = (128 * 128 + NGW - 1) / NGW; int prev = -1;
          for (int k = 0; k < per; ++k) { const int it = gw * per + k; if (it >= 128 * 128) break; const int c = it >> 7;
            s5_item<false>(wl, c, it & 127, c != prev, lane, A, X, part, s5a, bbcat, ccat, E, yb); prev = c; } }
    }
    XSYNC();
    {
        const int tid = fresh_tid();
        const int ch = bx * 32 + tid;
        if (tid < 32 && ch < 8192) {
            const float pre = s5a[16384 + ch], pim = s5a[24576 + ch];
            float sre = 0.f, sim = 0.f; float* Ep = E + (size_t)ch * 2;
#pragma unroll 1
            for (int c0 = 0; c0 < 128; c0 += 32) {
                f32x2 e[32];
#pragma unroll
                for (int k = 0; k < 32; ++k) e[k] = *(const f32x2*)(Ep + (size_t)(c0 + k) * 16384);
#pragma unroll
                for (int k = 0; k < 32; ++k) { *(f32x2*)(Ep + (size_t)(c0 + k) * 16384) = (f32x2){sre, sim};
                    const float nre = pre * sre - pim * sim + e[k].x, nim = pre * sim + pim * sre + e[k].y; sre = nre; sim = nim; }
            }
        }
    }
    XSYNC();
    for (int rep = 0; rep <= DUP_P6; ++rep) {
        const int lane = fresh_tid() & 63;
        LAS unsigned char* wl = lds + wave * 16384;
        { const int per = (144 * 128 + NGW - 1) / NGW; int prev = -1;
          for (int k = 0; k < per; ++k) { const int it = gw * per + k; if (it >= 144 * 128) break; const int c = it >> 7;
            s5_item<true>(wl, c, it & 127, c != prev, lane, A, X, part, s5a, bbcat, ccat, E, yb); prev = c; } }
    }
    XSYNC();
    {
        pg8::Gemm g{yb, Wt_glu, MTOK, 2 * DM, DM}; EpiGlu Ep{X, XB, part};
        if (G == 256) {
            { pg8::StaticOrder S; S.init(MP, 2 * DM, G, bx); pg8::gemm_phase<EpiGlu, pg8::StaticOrder, true, true>(lds, g, S, Ep); }
            XSYNC();
            if (bx < 64) { pg8::OneUnit S{32 + (bx >> 4), bx & 15}; pg8::gemm_phase<EpiGlu, pg8::OneUnit, true, true>(lds, g, S, Ep); }
            else if (bx < 112) { const int e = bx - 64; pg8::OneUnit S{pg8::early_panel(1, e >> 1), e & 1}; pg8::Gemm g8{XB, Wt_gu1, MTOK, 2 * DFF, DM}; EpiSwiglu<64> E8{part, ACT};
                pg8::gemm_phase<EpiSwiglu<64>, pg8::OneUnit, true, true>(lds, g8, S, E8); }
            else conv_items(A, ws, CV_A5, CV_A6, (bx - 112) * 8 + wave, 144 * 8, (LAS float*)(lds + wave * 16384), fresh_tid() & 63, true);
        } else {
            pg8::StaticOrder S; S.init(MTOK, 2 * DM, G, bx); pg8::gemm_phase<EpiGlu, pg8::StaticOrder, true, true>(lds, g, S, Ep);
            CONV_TAIL((MTOK / 256) * (2 * DM / 256), CV_A5, CV_A6);
        }
    }
    XSYNC();
    {
        pg8::Gemm g{XB, Wt_gu1, MTOK, 2 * DFF, DM}; EpiSwiglu<64> Ep{part, ACT};
        if (G == 256) { pg8::SkipOrder S; S.init(G, bx, 1); pg8::gemm_phase<EpiSwiglu<64>, pg8::SkipOrder, true, true>(lds, g, S, Ep);
            conv_items(A, ws, CV_A6, CV_A7, gw, NGW, (LAS float*)(lds + wave * 16384), fresh_tid() & 63, false); }
        else { pg8::StaticOrder S; S.init(MTOK, 2 * DFF, G, bx); pg8::gemm_phase<EpiSwiglu<64>, pg8::StaticOrder, true, true>(lds, g, S, Ep);
            CONV_TAIL((MTOK / 256) * (2 * DFF / 256), CV_A6, CV_A7); }
    }
    XSYNC();
    {
        pg8::Gemm g{ACT, Wt_d1, MTOK, DM, DFF};
        if (G == 256) { pg8::SplitOrder S; S.init(DFF, bx); EpiRes Ep{X, X + (size_t)MP * DM, X, nullptr, part, PB, DFF / 64};
            pg8::gemm_phase<EpiRes, pg8::SplitOrder, true, true>(lds, g, S, Ep); }
        else { pg8::StaticOrder S; S.init(MTOK, DM, G, bx); EpiRes Ep{X, X + (size_t)MP * DM, X, nullptr, part, nullptr, 0};
            pg8::gemm_phase<EpiRes, pg8::StaticOrder, true, true>(lds, g, S, Ep); }
    }
    XSYNC();
    {
        const int lane = fresh_tid() & 63;
        const bool deal = (G == 256);
        const int nrows = deal ? (gw < 1024 ? 1 : 8) : (MTOK - gw + NGW - 1) / NGW;
        for (int k = 0; k < nrows; ++k) {
            const int row = deal ? (gw < 1024 ? MP + gw : (gw - 1024) * 8 + k) : gw + k * NGW;
            float* xr = X + (size_t)row * DM; const float* gf = A.in[8];
            f32x4 v[8]; float s = 0.f;
#pragma unroll
            for (int j = 0; j < 8; ++j) { v[j] = *(const f32x4*)(xr + (lane + 64 * j) * 4); if (G == 256 && row >= MP) v[j] += pb_sum(PB, row - MP, (lane + 64 * j) * 4); s += sumsq4(v[j]); }
            s = wave_sum(s);
            const float rs = rsqrtf(s * (1.0f / 2048.0f) + RMS_EPS);
#pragma unroll
            for (int j = 0; j < 8; ++j) *(f32x4*)(xr + (lane + 64 * j) * 4) = v[j] * rs * *(const f32x4*)(gf + (lane + 64 * j) * 4);
        }
    }
}

extern "C" void kernel_launch(void* const* d_in, const int* in_sizes, int n_in, void* d_out, int out_size, void* d_ws, size_t ws_size, hipStream_t stream) {
    static int grid = 0;
    if (grid == 0) {
        if (n_in != 27 || ws_size < WS_END) { fprintf(stderr, "kernel_launch: need 27 inputs and >= %zu bytes of workspace (got %d, %zu)\n", (size_t)WS_END, n_in, ws_size); grid = -1; return; }
        int dev = 0, cus = 0, per_cu = 0;
        (void)hipGetDevice(&dev); (void)hipDeviceGetAttribute(&cus, hipDeviceAttributeMultiprocessorCount, dev);
        if (hipFuncSetAttribute((const void*)mega_fwd, hipFuncAttributeMaxDynamicSharedMemorySize, LDS_BYTES) != hipSuccess) { fprintf(stderr, "kernel_launch: hipFuncSetAttribute failed\n"); grid = -1; return; }
        if (hipOccupancyMaxActiveBlocksPerMultiprocessor(&per_cu, (const void*)mega_fwd, 512, LDS_BYTES) != hipSuccess || per_cu < 1) { fprintf(stderr, "kernel_launch: occupancy query failed (%d)\n", per_cu); (void)hipGetLastError(); per_cu = 1; }
        grid = cus * 1;
        if (grid > cus * per_cu) grid = cus * per_cu;
    }
    if (grid < 0) return;
    if (hipMemsetAsync((char*)d_ws + WS_BAR, 0, 16384, stream) != hipSuccess) { fprintf(stderr, "kernel_launch: memset of the barrier words failed\n"); return; }
    Args a{};
    for (int i = 0; i < 27; ++i) a.in[i] = (const float*)d_in[i];
    a.out = (float*)d_out; a.ws = (unsigned char*)d_ws;
    void* args[] = {&a};
    hipError_t e = hipLaunchCooperativeKernel((const void*)mega_fwd, dim3(grid), dim3(512), args, LDS_BYTES, stream);
    if (e != hipSuccess) fprintf(stderr, "cooperative launch failed: %s (grid %d)\n", hipGetErrorString(e), grid);
}
```
